# Optimizing an MI355X kernel written in HIP

```python
import math
import jax, jax.numpy as jnp
from jax import lax
import numpy as np


D_MODEL = 2048
BATCH = 4
SEQ = 4096
DEPTH = 4

N_MIXERS = 3
EPS = 1e-6

GLA_HEADS = 4
GLA_DK = D_MODEL // 2
GLA_DV = D_MODEL
GLA_HK = GLA_DK // GLA_HEADS
GLA_HV = GLA_DV // GLA_HEADS
GLA_RANK = 16
GLA_TAU = 16.0
GLA_CHUNK = 64
GLA_IN = 2 * GLA_DK + 2 * GLA_DV + GLA_RANK

POOL_WINDOWS = (2, 4, 8, 16)
POOL_GROUPS = 4
POOL_GW = D_MODEL // POOL_GROUPS

DIFF_HEADS = 8
DIFF_HD = D_MODEL // DIFF_HEADS // 2
DIFF_VD = 2 * DIFF_HD
Q_BLOCK = 128
REL_BUCKETS = 32
REL_MAX_DIST = 128

FFN_HIDDEN = ((8 * D_MODEL + 3 * 256 - 1) // (3 * 256)) * 256

N_GLA = (DEPTH + 2) // N_MIXERS
N_POOL = (DEPTH + 1) // N_MIXERS
N_DIFF = DEPTH // N_MIXERS

kernel_name = "hybrid_gla_pool_diffattn_trunk"


def rms_norm(x, g):
    xf = x.astype(jnp.float32)
    y = xf * lax.rsqrt(jnp.mean(xf * xf, axis=-1, keepdims=True) + EPS)
    return (y * g.astype(jnp.float32)).astype(x.dtype)


def gla_mixer(h, w_in, w_a2, b_a, g_norm, w_out):
    B, S, _ = h.shape
    f32 = jnp.float32
    C = GLA_CHUNK
    nc = S // C
    proj = h @ w_in
    q, k, v, r, a_lr = jnp.split(
        proj, [GLA_DK, 2 * GLA_DK, 2 * GLA_DK + GLA_DV, 2 * GLA_DK + 2 * GLA_DV], axis=-1)
    log_a = jax.nn.log_sigmoid((a_lr @ w_a2 + b_a).astype(f32)) / GLA_TAU

    def to_chunks(t, hd):
        return t.astype(f32).reshape(B, nc, C, GLA_HEADS, hd).transpose(1, 0, 3, 2, 4)

    qc = to_chunks(q, GLA_HK) * (GLA_HK ** -0.5)
    kc = to_chunks(k, GLA_HK)
    vc = to_chunks(v, GLA_HV)
    bc = jnp.cumsum(to_chunks(log_a, GLA_HK), axis=3)
    causal = jnp.tril(jnp.ones((C, C), dtype=bool))[:, :, None]

    def step(state, inp):
        qb, kb, vb, bb = inp
        o_inter = jnp.einsum('bhtd,bhdv->bhtv', qb * jnp.exp(bb), state)
        diff = bb[:, :, :, None, :] - bb[:, :, None, :, :]
        decay = jnp.exp(jnp.where(causal, diff, -jnp.inf))
        scores = jnp.einsum('bhtd,bhsd,bhtsd->bhts', qb, kb, decay)
        o_intra = jnp.einsum('bhts,bhsv->bhtv', scores, vb)
        b_last = bb[:, :, -1:, :]
        k_dec = kb * jnp.exp(b_last - bb)
        state = jnp.exp(b_last[:, :, 0, :, None]) * state + jnp.einsum('bhsd,bhsv->bhdv', k_dec, vb)
        return state, o_inter + o_intra

    s0 = jnp.zeros((B, GLA_HEADS, GLA_HK, GLA_HV), f32)
    _, o = lax.scan(step, s0, (qc, kc, vc, bc))
    o = o.transpose(1, 0, 3, 2, 4).reshape(B, S, GLA_HEADS, GLA_HV)
    o = rms_norm(o, g_norm).reshape(B, S, GLA_DV) * jax.nn.silu(r.astype(f32))
    return o.astype(h.dtype) @ w_out


def pool_mixer(h, w_pool, scale):
    B, S, D = h.shape
    f32 = jnp.float32
    hf = h.astype(f32)
    cs = jnp.pad(jnp.cumsum(hf, axis=1), ((0, 0), (1, 0), (0, 0)))
    t = jnp.arange(S)
    outs = []
    for g, w in enumerate(POOL_WINDOWS):
        c = cs[:, :, g * POOL_GW:(g + 1) * POOL_GW]
        start = jnp.maximum(t + 1 - w, 0)
        count = (t + 1 - start).astype(f32)
        pooled = (c[:, 1:] - c[:, start]) / count[None, :, None]
        outs.append(pooled - hf[:, :, g * POOL_GW:(g + 1) * POOL_GW])
    y = jnp.stack(outs, axis=2).astype(h.dtype)
    y = jnp.einsum('bsgc,gcd->bsgd', y, w_pool).reshape(B, S, D)
    return y * scale


def rel_bucket(rel):
    n = jnp.maximum(rel, 0)
    max_exact = REL_BUCKETS // 2
    nf = jnp.maximum(n, 1).astype(jnp.float32)
    large = max_exact + (jnp.log(nf / max_exact) / math.log(REL_MAX_DIST / max_exact)
                         * (REL_BUCKETS - max_exact)).astype(jnp.int32)
    large = jnp.minimum(large, REL_BUCKETS - 1)
    return jnp.where(n < max_exact, n, large)


def diff_attn_mixer(h, w_in, q_gain, k_gain, lam_params, sub_gain, w_out, rel_table, layer_idx):
    B, S, D = h.shape
    f32 = jnp.float32
    H2 = 2 * DIFF_HEADS
    proj = h @ w_in
    q, k, v = jnp.split(proj, [D, 2 * D], axis=-1)
    q = rms_norm(q.reshape(B, S, H2, DIFF_HD), q_gain).transpose(0, 2, 1, 3)
    k = rms_norm(k.reshape(B, S, H2, DIFF_HD), k_gain).transpose(0, 2, 1, 3)
    v = v.reshape(B, S, DIFF_HEADS, DIFF_VD).transpose(0, 2, 1, 3)
    lam_init = 0.8 - 0.6 * math.exp(-0.3 * layer_idx)
    lp = lam_params.astype(f32)
    lam = jnp.exp(jnp.sum(lp[0] * lp[1])) - jnp.exp(jnp.sum(lp[2] * lp[3])) + lam_init
    nb = S // Q_BLOCK
    qb = q.reshape(B, H2, nb, Q_BLOCK, DIFF_HD).transpose(2, 0, 1, 3, 4)
    kpos = jnp.arange(S)
    scale = DIFF_HD ** -0.5

    def block(args):
        qblk, bi = args
        qpos = bi * Q_BLOCK + jnp.arange(Q_BLOCK)
        rel = qpos[:, None] - kpos[None, :]
        bias = rel_table[rel_bucket(rel)].astype(f32).transpose(2, 0, 1)
        logits = jnp.einsum('bhqd,bhkd->bhqk', qblk, k).astype(f32) * scale + bias
        logits = jnp.where(rel >= 0, logits, -jnp.inf)
        p = jax.nn.softmax(logits, axis=-1).reshape(B, DIFF_HEADS, 2, Q_BLOCK, S)
        attn = p[:, :, 0] - lam * p[:, :, 1]
        return jnp.einsum('bhqk,bhkd->bhqd', attn.astype(v.dtype), v)

    o = lax.map(block, (qb, jnp.arange(nb)))
    o = o.transpose(1, 0, 3, 2, 4).reshape(B, S, DIFF_HEADS, DIFF_VD)
    o = rms_norm(o, sub_gain) * (1.0 - lam_init)
    return o.reshape(B, S, D).astype(h.dtype) @ w_out


def swiglu(h, w_gu, w_down):
    g, u = jnp.split(h @ w_gu, 2, axis=-1)
    return (jax.nn.silu(g) * u) @ w_down


def setup_inputs(seed: int = 0) -> dict:
    key = jax.random.key(seed)
    ks = jax.random.split(key, 20)
    D = D_MODEL
    nrm = jax.random.normal
    out_scale = (2 * DEPTH) ** -0.5
    return {
        "x": nrm(ks[0], (BATCH, SEQ, D), jnp.float32),
        "norm_g": 1.0 + 0.02 * nrm(ks[1], (DEPTH, 2, D), jnp.float32),
        "gla_w_in": nrm(ks[2], (N_GLA, D, GLA_IN), jnp.float32) * D ** -0.5,
        "gla_w_a2": nrm(ks[3], (N_GLA, GLA_RANK, GLA_DK), jnp.float32) * GLA_RANK ** -0.5,
        "gla_b_a": 0.1 * nrm(ks[4], (N_GLA, GLA_DK), jnp.float32),
        "gla_g_norm": 1.0 + 0.02 * nrm(ks[5], (N_GLA, GLA_HV), jnp.float32),
        "gla_w_out": nrm(ks[6], (N_GLA, GLA_DV, D), jnp.float32) * GLA_DV ** -0.5 * out_scale,
        "pool_w": nrm(ks[7], (N_POOL, POOL_GROUPS, POOL_GW, POOL_GW), jnp.float32) * POOL_GW ** -0.5,
        "pool_scale": 1.0 + 0.1 * nrm(ks[8], (N_POOL, D), jnp.float32),
        "diff_w_in": nrm(ks[9], (N_DIFF, D, 3 * D), jnp.float32) * D ** -0.5,
        "diff_q_gain": 1.0 + 0.02 * nrm(ks[10], (N_DIFF, DIFF_HD), jnp.float32),
        "diff_k_gain": 1.0 + 0.02 * nrm(ks[11], (N_DIFF, DIFF_HD), jnp.float32),
        "diff_lambda": 0.1 * nrm(ks[12], (N_DIFF, 4, DIFF_HD), jnp.float32),
        "diff_sub_gain": 1.0 + 0.02 * nrm(ks[13], (N_DIFF, DIFF_VD), jnp.float32),
        "diff_w_out": nrm(ks[14], (N_DIFF, D, D), jnp.float32) * D ** -0.5 * out_scale,
        "rel_bias": 0.5 * nrm(ks[15], (REL_BUCKETS, 2 * DIFF_HEADS), jnp.float32),
        "ffn_w_gu": nrm(ks[16], (DEPTH, D, 2 * FFN_HIDDEN), jnp.float32) * D ** -0.5,
        "ffn_w_down": nrm(ks[17], (DEPTH, FFN_HIDDEN, D), jnp.float32) * FFN_HIDDEN ** -0.5 * out_scale,
    }


def reference(x, norm_g, gla_w_in, gla_w_a2, gla_b_a, gla_g_norm, gla_w_out,
              pool_w, pool_scale, diff_w_in, diff_q_gain, diff_k_gain, diff_lambda,
              diff_sub_gain, diff_w_out, rel_bias, ffn_w_gu, ffn_w_down):
    for i in range(DEPTH):
        kind = i % N_MIXERS
        slot = i // N_MIXERS
        h = rms_norm(x, norm_g[i, 0])
        if kind == 0:
            y = gla_mixer(h, gla_w_in[slot], gla_w_a2[slot], gla_b_a[slot],
                          gla_g_norm[slot], gla_w_out[slot])
        elif kind == 1:
            y = pool_mixer(h, pool_w[slot], pool_scale[slot])
        else:
            y = diff_attn_mixer(h, diff_w_in[slot], diff_q_gain[slot], diff_k_gain[slot],
                                diff_lambda[slot], diff_sub_gain[slot], diff_w_out[slot],
                                rel_bias, i)
        x = x + y.astype(x.dtype)
        x = x + swiglu(rms_norm(x, norm_g[i, 1]), ffn_w_gu[i], ffn_w_down[i]).astype(x.dtype)
    return x
```

```cpp
#include <hip/hip_runtime.h>
#include <hip/hip_cooperative_groups.h>
#include <cstdio>
#include <cstdint>
namespace cg = cooperative_groups;

namespace pg8 {
#define PG8_LAS __attribute__((address_space(3)))
typedef unsigned short bf16_t;
typedef short bf16x8 __attribute__((ext_vector_type(8)));
typedef float f32x4 __attribute__((ext_vector_type(4)));
typedef unsigned u32x4 __attribute__((ext_vector_type(4)));
constexpr int BM = 256, BK = 64, HALF = 128, HTB = HALF * BK * 2, STAGE_BYTES = 8 * HTB, NXCD = 8, WGM = 8;

__host__ __device__ __forceinline__ int lds_byte(int r, int c) { const int st = (r >> 4) * 2 + (c >> 5), rr = r & 15, cc = c & 31, ob = rr * 64 + cc * 2; return st * 1024 + (ob ^ (((ob >> 9) & 1) << 5)); }
__host__ __device__ __forceinline__ void stage_rc(int b, int& R, int& C) { const int st = b / 1024, sb = b % 1024, swz = sb ^ (((sb >> 9) & 1) << 5); R = (st >> 1) * 16 + swz / 64; C = (st & 1) * 32 + (swz % 64) / 2; }
__host__ __device__ __forceinline__ int perm32(int rho) { const int n = rho >> 4, i = rho & 15; return 8 * (i >> 2) + 4 * n + (i & 3); }

struct Unit { int pm, pn; };
struct Gemm { const bf16_t* A; const bf16_t* Bt; int M, N, K, lda, agrp;
    __device__ __forceinline__ size_t aofs(int pn) const { return agrp ? (size_t)(pn >> 1) * 1024u : (size_t)0; } };

struct StaticOrder {
    int nM, nN, nwg, G, c, wgm;
    __host__ __device__ void init(int M, int N, int G_, int c_, int wgm_ = WGM) { nM = M / BM; nN = N / BM; nwg = nM * nN; G = G_; c = c_; wgm = wgm_; }
    __host__ __device__ bool next(int i, Unit& u) const {
        const long L = (long)i * G + c; if (L >= nwg) return false;
        int wgid = (int)L; { const int q = nwg / NXCD, r = nwg % NXCD, xcd = wgid % NXCD, off = wgid / NXCD; wgid = (xcd < r ? xcd * (q + 1) : r * (q + 1) + (xcd - r) * q) + off; }
        const int nig = wgm * nN, gid = wgid / nig, fm = gid * wgm, gsz = (nM - fm) < wgm ? (nM - fm) : wgm;
        u.pm = fm + ((wgid % nig) % gsz); u.pn = (wgid % nig) / gsz; return true;
    }
    __device__ __forceinline__ void a_ready(const Unit&) const {}
    __device__ __forceinline__ void done(const Unit&) const {}
};

typedef float f32x2_t __attribute__((ext_vector_type(2))); typedef __bf16 bf16x2_t __attribute__((ext_vector_type(2)));
__device__ __forceinline__ unsigned cvt_pk_bf16(float lo, float hi) { const f32x2_t v = {lo, hi}; const bf16x2_t b = __builtin_convertvector(v, bf16x2_t); return __builtin_bit_cast(unsigned, b); }

struct EpiStore {
    static constexpr bool PERM = true, AFTER_DRAIN = false;
    bf16_t* O; int ldc;
    __device__ __forceinline__ void init(f32x4 (&acc)[2][2][4][2], const Unit&, int, int, int, int) const {
#pragma unroll
        for (int a = 0; a < 2; ++a)
#pragma unroll
            for (int b = 0; b < 2; ++b)
#pragma unroll
                for (int m = 0; m < 4; ++m)
#pragma unroll
                    for (int n = 0; n < 2; ++n) acc[a][b][m][n] = (f32x4){0.f, 0.f, 0.f, 0.f};
    }
    __device__ __forceinline__ void operator()(const f32x4 (&acc)[2][2][4][2], const Unit& u, int wr, int wc, int fr, int fq) const {
        const int row0 = u.pm * BM + wr * 64 + fr; const int col0 = u.pn * BM + wc * 32 + 8 * fq;
#pragma unroll
        for (int ai = 0; ai < 2; ++ai)
#pragma unroll
            for (int m = 0; m < 4; ++m) { bf16_t* rowp = O + (size_t)(row0 + ai * HALF + m * 16) * ldc + col0;
#pragma unroll
                for (int bj = 0; bj < 2; ++bj) { const f32x4 v0 = acc[ai][bj][m][0], v1 = acc[ai][bj][m][1];
                    u32x4 w; w.x = cvt_pk_bf16(v0[0], v0[1]); w.y = cvt_pk_bf16(v0[2], v0[3]); w.z = cvt_pk_bf16(v1[0], v1[1]); w.w = cvt_pk_bf16(v1[2], v1[3]);
                    *(u32x4*)(rowp + bj * HALF) = w; } }
    }
};
__device__ __forceinline__ float silu_f(float g) { return g * __builtin_amdgcn_rcpf(1.0f + __expf(-g)); }
struct EpiSwiglu {
    static constexpr bool PERM = true, AFTER_DRAIN = false;
    bf16_t* O; int ldc;
    __device__ __forceinline__ void init(f32x4 (&acc)[2][2][4][2], const Unit&, int, int, int, int) const {
#pragma unroll
        for (int a = 0; a < 2; ++a)
#pragma unroll
            for (int b = 0; b < 2; ++b)
#pragma unroll
                for (int m = 0; m < 4; ++m)
#pragma unroll
                    for (int n = 0; n < 2; ++n) acc[a][b][m][n] = (f32x4){0.f, 0.f, 0.f, 0.f};
    }
    __device__ __forceinline__ void operator()(const f32x4 (&acc)[2][2][4][2], const Unit& u, int wr, int wc, int fr, int fq) const {
        const int row0 = u.pm * BM + wr * 64 + fr; const int col0 = u.pn * HALF + wc * 32 + 8 * fq;
#pragma unroll
        for (int ai = 0; ai < 2; ++ai)
#pragma unroll
            for (int m = 0; m < 4; ++m) { bf16_t* rowp = O + (size_t)(row0 + ai * HALF + m * 16) * ldc + col0;
                const f32x4 g0 = acc[ai][0][m][0], g1 = acc[ai][0][m][1], u0 = acc[ai][1][m][0], u1 = acc[ai][1][m][1];
                u32x4 w; w.x = cvt_pk_bf16(silu_f(g0[0]) * u0[0], silu_f(g0[1]) * u0[1]); w.y = cvt_pk_bf16(silu_f(g0[2]) * u0[2], silu_f(g0[3]) * u0[3]);
                w.z = cvt_pk_bf16(silu_f(g1[0]) * u1[0], silu_f(g1[1]) * u1[1]); w.w = cvt_pk_bf16(silu_f(g1[2]) * u1[2], silu_f(g1[3]) * u1[3]);
                *(u32x4*)rowp = w; asm volatile("" ::: "memory"); }
    }
};
struct EpiResid {
    static constexpr bool PERM = true, AFTER_DRAIN = false;
    const void* Xin; void* Xout; int ldc; int out_f32;
    __device__ __forceinline__ void init(f32x4 (&acc)[2][2][4][2], const Unit& u, int wr, int wc, int fr, int fq) const {
        const int row0 = u.pm * BM + wr * 64 + fr; const int col0 = u.pn * BM + wc * 32 + 8 * fq;
        { const bf16_t* xi = (const bf16_t*)Xin;
#pragma unroll
            for (int ai = 0; ai < 2; ++ai)
#pragma unroll
                for (int m = 0; m < 4; ++m)
#pragma unroll
                    for (int bj = 0; bj < 2; ++bj) { const u32x4 w = *(const u32x4*)(xi + (size_t)(row0 + ai * HALF + m * 16) * ldc + col0 + bj * HALF);
                        acc[ai][bj][m][0] = (f32x4){__uint_as_float(w.x << 16), __uint_as_float(w.x & 0xffff0000u), __uint_as_float(w.y << 16), __uint_as_float(w.y & 0xffff0000u)};
                        acc[ai][bj][m][1] = (f32x4){__uint_as_float(w.z << 16), __uint_as_float(w.z & 0xffff0000u), __uint_as_float(w.w << 16), __uint_as_float(w.w & 0xffff0000u)}; }
        }
    }
    __device__ __forceinline__ void operator()(const f32x4 (&acc)[2][2][4][2], const Unit& u, int wr, int wc, int fr, int fq) const {
        const int row0 = u.pm * BM + wr * 64 + fr; const int col0 = u.pn * BM + wc * 32 + 8 * fq;
        if (out_f32) { float* xo = (float*)Xout;
#pragma unroll
            for (int ai = 0; ai < 2; ++ai)
#pragma unroll
                for (int m = 0; m < 4; ++m)
#pragma unroll
                    for (int bj = 0; bj < 2; ++bj)
#pragma unroll
                        for (int n = 0; n < 2; ++n) *(f32x4*)(xo + (size_t)(row0 + ai * HALF + m * 16) * ldc + col0 + bj * HALF + 4 * n) = acc[ai][bj][m][n];
        } else { bf16_t* xo = (bf16_t*)Xout;
#pragma unroll
            for (int ai = 0; ai < 2; ++ai)
#pragma unroll
                for (int m = 0; m < 4; ++m)
#pragma unroll
                    for (int bj = 0; bj < 2; ++bj) { const f32x4 v0 = acc[ai][bj][m][0], v1 = acc[ai][bj][m][1];
                        u32x4 w; w.x = cvt_pk_bf16(v0[0], v0[1]); w.y = cvt_pk_bf16(v0[2], v0[3]); w.z = cvt_pk_bf16(v1[0], v1[1]); w.w = cvt_pk_bf16(v1[2], v1[3]);
                        *(u32x4*)(xo + (size_t)(row0 + ai * HALF + m * 16) * ldc + col0 + bj * HALF) = w; }
        }
    }
};

template <class Epi, class Sched, bool ALIGN_EPI = false, bool SP2 = false>
__device__ __forceinline__ void gemm_phase(PG8_LAS unsigned char* lds, const Gemm g, const Sched& S, const Epi& E) {
    int tid_o = threadIdx.x; asm volatile("" : "+v"(tid_o)); const int tid = tid_o, wid = __builtin_amdgcn_readfirstlane(tid >> 6), lane = tid & 63, wr = wid >> 2, wc = wid & 3, fr = lane & 15, fq = lane >> 4;
    const int K = g.K, nt = K / BK;
    unsigned voffA[2], voffB[2];
#pragma unroll
    for (int i = 0; i < 2; ++i) { int R, C; stage_rc(tid * 16 + i * 8192, R, C); const int Rb = Epi::PERM ? ((R & ~31) + perm32(R & 31)) : R;
        voffA[i] = (unsigned)(R * g.lda + C) * 2u; voffB[i] = (unsigned)(Rb * K + C) * 2u; }
    const size_t kstep = (size_t)(BK * 2);
    const size_t hstepA = (size_t)HALF * g.lda * 2, hstepB = (size_t)HALF * K * 2;
    const size_t tstepA = 2 * hstepA, tstepB = 2 * hstepB;
    const unsigned ldsw = (unsigned)wid * 1024u;
    const int aoff = lds_byte(wr * 64 + fr, fq * 8), boff = lds_byte(wc * 32 + fr, fq * 8);
#define PG8_SA(b, h) (((b) * 2 + (h)) * HTB)
#define PG8_SB(b, h) ((4 + (b) * 2 + (h)) * HTB)
#define PG8_STAGE(bufoff, gbase, voff) do { _Pragma("unroll") for (int _i = 0; _i < 2; ++_i) \
        __builtin_amdgcn_global_load_lds((const unsigned*)((const char*)(gbase) + (voff)[_i]), (PG8_LAS unsigned*)(lds + (bufoff) + ldsw + _i * 8192), 16, 0, 0); } while (0)
#define PG8_LDA(dst, b, h) do { _Pragma("unroll") for (int m = 0; m < 4; ++m) _Pragma("unroll") for (int k = 0; k < 2; ++k) dst[m][k] = *(const PG8_LAS bf16x8*)(lds + PG8_SA(b, h) + aoff + m * 2048 + k * 1024); } while (0)
#define PG8_LDB(dst, b, h) do { _Pragma("unroll") for (int n = 0; n < 2; ++n) _Pragma("unroll") for (int k = 0; k < 2; ++k) dst[n][k] = *(const PG8_LAS bf16x8*)(lds + PG8_SB(b, h) + boff + n * 2048 + k * 1024); } while (0)
#define PG8_MMA(ai, bj, At, Bt) do { __builtin_amdgcn_s_setprio(1); _Pragma("unroll") for (int m = 0; m < 4; ++m) _Pragma("unroll") for (int n = 0; n < 2; ++n) _Pragma("unroll") for (int k = 0; k < 2; ++k) \
        acc[ai][bj][m][n] = __builtin_amdgcn_mfma_f32_16x16x32_bf16(Bt[n][k], At[m][k], acc[ai][bj][m][n], 0, 0, 0); __builtin_amdgcn_s_setprio(0); } while (0)
#define PG8_WAIT_V(n) asm volatile("s_waitcnt vmcnt(" #n ")" ::: "memory")
#define PG8_WAIT_L(n) asm volatile("s_waitcnt lgkmcnt(" #n ")" ::: "memory")
#define PG8_BAR __builtin_amdgcn_s_barrier()
#define PG8_SCHED __builtin_amdgcn_sched_barrier(0)
    Unit cur, nxt; int ui = 0;
    if (!S.next(0, cur)) return;
    f32x4 acc[2][2][4][2];
    E.init(acc, cur, wr, wc, fr, fq);
    bf16x8 At[4][2], B0[2][2], B1[2][2];
    const char* cA = (const char*)g.A + (size_t)cur.pm * tstepA + g.aofs(cur.pn); const char* cB = (const char*)g.Bt + (size_t)cur.pn * tstepB;
    S.a_ready(cur);
    if constexpr (SP2) {
        PG8_STAGE(PG8_SB(0, 0), cB, voffB); PG8_STAGE(PG8_SB(0, 1), cB + hstepB, voffB); PG8_STAGE(PG8_SA(0, 0), cA, voffA); PG8_STAGE(PG8_SA(0, 1), cA + hstepA, voffA);
        if (wr == 1) PG8_BAR;
        PG8_WAIT_V(2); PG8_BAR;
        PG8_STAGE(PG8_SB(1, 0), cB + kstep, voffB); PG8_STAGE(PG8_SA(1, 0), cA + kstep, voffA); PG8_STAGE(PG8_SB(1, 1), cB + hstepB + kstep, voffB);
        PG8_WAIT_V(6); PG8_BAR;
    } else {
        PG8_STAGE(PG8_SB(0, 0), cB, voffB); PG8_STAGE(PG8_SA(0, 0), cA, voffA); PG8_STAGE(PG8_SB(0, 1), cB + hstepB, voffB); PG8_STAGE(PG8_SA(0, 1), cA + hstepA, voffA);
        if (wr == 1) PG8_BAR;
        PG8_WAIT_V(4); PG8_BAR;
        PG8_STAGE(PG8_SB(1, 0), cB + kstep, voffB); PG8_STAGE(PG8_SA(1, 0), cA + kstep, voffA); PG8_STAGE(PG8_SB(1, 1), cB + hstepB + kstep, voffB);
        PG8_WAIT_V(6); PG8_BAR;
    }
    for (;;) {
        const bool has_next = S.next(ui + 1, nxt);
        const char* nA = has_next ? (const char*)g.A + (size_t)nxt.pm * tstepA + g.aofs(nxt.pn) : cA; const char* nB = has_next ? (const char*)g.Bt + (size_t)nxt.pn * tstepB : cB;
        for (int t = 0; t < nt; t += 2) {
            const bool last = (t == nt - 2);
            const char* a1 = cA + (size_t)(t + 1) * kstep;
            const char* a2 = last ? nA : cA + (size_t)(t + 2) * kstep; const char* b2 = last ? nB : cB + (size_t)(t + 2) * kstep;
            const char* a3 = a2 + kstep; const char* b3 = b2 + kstep;
            if (last && has_next) S.a_ready(nxt);
            if constexpr (SP2) {
            PG8_LDB(B0, 0, 0); PG8_LDB(B1, 0, 1); PG8_SCHED; PG8_LDA(At, 0, 0); PG8_STAGE(PG8_SA(1, 1), a1 + hstepA, voffA);
            PG8_WAIT_V(8); PG8_WAIT_L(0); PG8_BAR; PG8_MMA(0, 0, At, B0); PG8_MMA(0, 1, At, B1); PG8_BAR; PG8_SCHED;
            PG8_LDA(At, 0, 1); PG8_STAGE(PG8_SB(0, 0), b2, voffB); PG8_STAGE(PG8_SB(0, 1), b2 + hstepB, voffB); PG8_STAGE(PG8_SA(0, 0), a2, voffA);
            PG8_WAIT_V(8); PG8_WAIT_L(0); PG8_BAR; PG8_MMA(1, 0, At, B0); PG8_MMA(1, 1, At, B1); PG8_BAR; PG8_SCHED;
            PG8_LDB(B0, 1, 0); PG8_LDB(B1, 1, 1); PG8_SCHED; PG8_LDA(At, 1, 0); PG8_STAGE(PG8_SA(0, 1), a2 + hstepA, voffA);
            PG8_WAIT_V(8); PG8_WAIT_L(0); PG8_BAR; PG8_MMA(0, 0, At, B0); PG8_MMA(0, 1, At, B1); PG8_BAR; PG8_SCHED;
            PG8_LDA(At, 1, 1); PG8_STAGE(PG8_SB(1, 0), b3, voffB); PG8_STAGE(PG8_SB(1, 1), b3 + hstepB, voffB); PG8_STAGE(PG8_SA(1, 0), a3, voffA);
            PG8_WAIT_V(8); PG8_WAIT_L(0); PG8_BAR; PG8_MMA(1, 0, At, B0); PG8_MMA(1, 1, At, B1); PG8_BAR; PG8_SCHED;
            } else {
            PG8_LDB(B0, 0, 0); PG8_SCHED; PG8_LDA(At, 0, 0); PG8_STAGE(PG8_SA(1, 1), a1 + hstepA, voffA);
            PG8_WAIT_L(8); PG8_BAR; PG8_WAIT_L(0); PG8_MMA(0, 0, At, B0); PG8_BAR; PG8_SCHED;
            PG8_LDB(B1, 0, 1); PG8_STAGE(PG8_SB(0, 0), b2, voffB);
            PG8_BAR; PG8_WAIT_L(0); PG8_MMA(0, 1, At, B1); PG8_BAR;
            PG8_LDA(At, 0, 1); PG8_STAGE(PG8_SA(0, 0), a2, voffA);
            PG8_BAR; PG8_WAIT_L(0); PG8_MMA(1, 0, At, B0); PG8_BAR; PG8_SCHED;
            PG8_STAGE(PG8_SB(0, 1), b2 + hstepB, voffB);
            PG8_WAIT_V(6); PG8_BAR; PG8_MMA(1, 1, At, B1); PG8_BAR;
            PG8_LDB(B0, 1, 0); PG8_SCHED; PG8_LDA(At, 1, 0); PG8_STAGE(PG8_SA(0, 1), a2 + hstepA, voffA);
            PG8_WAIT_L(8); PG8_BAR; PG8_WAIT_L(0); PG8_MMA(0, 0, At, B0); PG8_BAR; PG8_SCHED;
            PG8_LDB(B1, 1, 1); PG8_STAGE(PG8_SB(1, 0), b3, voffB);
            PG8_BAR; PG8_WAIT_L(0); PG8_MMA(0, 1, At, B1); PG8_BAR;
            PG8_LDA(At, 1, 1); PG8_STAGE(PG8_SA(1, 0), a3, voffA);
            PG8_BAR; PG8_WAIT_L(0); PG8_MMA(1, 0, At, B0); PG8_BAR; PG8_SCHED;
            PG8_STAGE(PG8_SB(1, 1), b3 + hstepB, voffB);
            PG8_WAIT_V(6); PG8_BAR; PG8_MMA(1, 1, At, B1); PG8_BAR;
            }
        }
        if constexpr (ALIGN_EPI) { if (wr == 0) PG8_BAR; }
        if constexpr (!Epi::AFTER_DRAIN) { E(acc, cur, wr, wc, fr, fq); S.done(cur); }
        if (!has_next) break;
        E.init(acc, nxt, wr, wc, fr, fq);
        cur = nxt; cA = nA; cB = nB; ++ui;
        if constexpr (ALIGN_EPI) { if (wr == 1) PG8_BAR; }
    }
    PG8_WAIT_V(0);
    if constexpr (!ALIGN_EPI) { if (wr == 0) PG8_BAR; }
    PG8_BAR;
    if constexpr (Epi::AFTER_DRAIN) { E.fused(acc, cur, wr, wc, fr, fq, lds, wid, lane); S.done(cur); }
#undef PG8_SA
#undef PG8_SB
#undef PG8_STAGE
#undef PG8_LDA
#undef PG8_LDB
#undef PG8_MMA
#undef PG8_WAIT_V
#undef PG8_WAIT_L
#undef PG8_BAR
#undef PG8_SCHED
}}

constexpr int NB = 4, SEQ = 4096, DM = 2048, M = NB * SEQ;
constexpr int GLA_H = 4, GLA_DK = 1024, GLA_DV = 2048, GLA_HK = 256, GLA_HV = 512, GLA_RANK = 16, GLA_C = 64, GLA_NC = SEQ / GLA_C, GLA_IN = 6160, GLA_INP = 6400  , GLA_PP = 6144  ;
constexpr int FF = 5632, DIFF_IN = 6144;
constexpr float EPS = 1e-6f, LOG2E = 1.4426950408889634f;
constexpr float LAM_INIT = 0.47071302f;
constexpr float QSCALE = 0.08838834764831845f * LOG2E;

constexpr size_t MiB = 1u << 20;
constexpr size_t WS_GLA_IN = 0;
constexpr size_t WS_GLA_OUT = 50 * MiB;
constexpr size_t WS_POOL = 66 * MiB;
constexpr size_t WS_DIFF_IN = 68 * MiB;
constexpr size_t WS_DIFF_OUT = 92 * MiB;
constexpr size_t WS_GU = 100 * MiB;
constexpr size_t WS_DOWN = 276 * MiB;
constexpr size_t WS_HN = 364 * MiB;
constexpr size_t WS_PROJ = 428 * MiB;
constexpr size_t WS_HID = 628 * MiB;
constexpr size_t WS_QT = 804 * MiB, WS_KT = 836 * MiB, WS_KH = 868 * MiB;
constexpr size_t WS_DEC = 900 * MiB;
constexpr size_t WS_OI = 901 * MiB;
constexpr size_t WS_OG = 1029 * MiB;
constexpr size_t WS_BAR = 1093 * MiB;
constexpr size_t WS_XB = 1094 * MiB;
constexpr size_t WS_END = 1158 * MiB;

constexpr int MISC_OFF = 152576;
constexpr int LDS_BYTES = 155648;
constexpr int NWAVES = 8, NTHR = 512;

#define LAS __attribute__((address_space(3)))
typedef unsigned short bf16_t;
typedef short bf16x8 __attribute__((ext_vector_type(8)));
typedef short s16x4 __attribute__((ext_vector_type(4)));
typedef float f32x4 __attribute__((ext_vector_type(4)));
typedef float f32x2 __attribute__((ext_vector_type(2)));
typedef unsigned u32x4 __attribute__((ext_vector_type(4)));
typedef unsigned u32x2 __attribute__((ext_vector_type(2)));

__device__ __forceinline__ unsigned cvtpk(float lo, float hi) { return pg8::cvt_pk_bf16(lo, hi); }
__device__ __forceinline__ float bflo(unsigned u) { return __uint_as_float(u << 16); }
__device__ __forceinline__ float bfhi(unsigned u) { return __uint_as_float(u & 0xffff0000u); }
__device__ __forceinline__ float bf2f(bf16_t u) { return __uint_as_float((unsigned)u << 16); }
__device__ __forceinline__ float wave_sum(float v) {
#pragma unroll
    for (int o = 1; o < 64; o <<= 1) v += __shfl_xor(v, o);
    return v;
}
__device__ __forceinline__ f32x4 mma16(bf16x8 a, bf16x8 b, f32x4 c) { return __builtin_amdgcn_mfma_f32_16x16x32_bf16(a, b, c, 0, 0, 0); }
__device__ __forceinline__ bf16x8 frag_rowk(const LAS bf16_t* T, int pitch, int r0, int k0, int fr, int fq) {
    return *(const LAS bf16x8*)(T + (r0 + fr) * pitch + k0 + 8 * fq);
}
__device__ __forceinline__ bf16x8 frag_tr2(const LAS bf16_t* T, int pitch, int rowA, int rowB, int c0, int fr) {
    const LAS bf16_t* pa = T + (rowA + (fr >> 2)) * pitch + c0 + 4 * (fr & 3);
    const LAS bf16_t* pb = T + (rowB + (fr >> 2)) * pitch + c0 + 4 * (fr & 3);
    const s16x4 a = __builtin_amdgcn_ds_read_tr16_b64_v4i16((LAS s16x4*)pa);
    const s16x4 b = __builtin_amdgcn_ds_read_tr16_b64_v4i16((LAS s16x4*)pb);
    return (bf16x8){a[0], a[1], a[2], a[3], b[0], b[1], b[2], b[3]};
}
__device__ __forceinline__ bf16x8 frag_tr(const LAS bf16_t* T, int pitch, int k0, int c0, int fr, int fq) { return frag_tr2(T, pitch, k0 + 8 * fq, k0 + 8 * fq + 4, c0, fr); }

struct Args { const float* in[18]; float* out; unsigned char* ws; int lo, hi; };

__device__ __forceinline__ void conv_matrix(const float* W, int K, int N, int Nv, bf16_t* WT, int mode, LAS float* scr, int gw, int ngw, int lane, const float* nscale = nullptr) {
    const int nblk = Nv / 64, nitems = (K / 64) * nblk;
    const int r4 = lane >> 4, c4 = (lane & 15) * 4;
    for (int it = gw; it < nitems; it += ngw) {
        const int kb = it / nblk, nb = it % nblk, k0 = 64 * kb, n0 = 64 * nb;
        const bool ok = (n0 + c4) < N;
        const float* src = W + (size_t)(k0 + r4) * N + n0 + c4;
        f32x4 v[16];
#pragma unroll
        for (int i = 0; i < 16; ++i) v[i] = ok ? *(const f32x4*)(src + (size_t)(4 * i) * N) : (f32x4){0.f, 0.f, 0.f, 0.f};
        if (nscale) { const f32x4 s4 = *(const f32x4*)(nscale + n0 + c4);
#pragma unroll
            for (int i = 0; i < 16; ++i) v[i] = v[i] * s4; }
#pragma unroll
        for (int i = 0; i < 16; ++i) { LAS float* q = scr + (4 * i + r4) * 65 + c4; q[0] = v[i][0]; q[1] = v[i][1]; q[2] = v[i][2]; q[3] = v[i][3]; }
        asm volatile("s_waitcnt lgkmcnt(0)" ::: "memory");
        int d0 = n0;
        if (mode == 1) { d0 = (n0 < FF) ? (256 * (n0 / 128) + (n0 % 128)) : (256 * ((n0 - FF) / 128) + 128 + ((n0 - FF) % 128)); }
        const int ns = lane >> 3, c = lane & 7;
        bf16_t* dst = WT + (size_t)(d0 + ns) * K + k0 + 8 * c;
        const LAS float* sp = scr + (8 * c) * 65 + ns;
#pragma unroll
        for (int i = 0; i < 8; ++i) { u32x4 o;
            o.x = cvtpk(sp[8 * i + 0 * 65], sp[8 * i + 1 * 65]); o.y = cvtpk(sp[8 * i + 2 * 65], sp[8 * i + 3 * 65]);
            o.z = cvtpk(sp[8 * i + 4 * 65], sp[8 * i + 5 * 65]); o.w = cvtpk(sp[8 * i + 6 * 65], sp[8 * i + 7 * 65]);
            *(u32x4*)(dst + (size_t)(8 * i) * K) = o; }
        asm volatile("s_waitcnt lgkmcnt(0)" ::: "memory");
    }
}

template <int NR>
__device__ __forceinline__ void norm_rows(const float* xrow, const float* g, bf16_t* orow, bf16_t* crow, int lane) {
    f32x4 v[NR][8]; float s[NR];
#pragma unroll
    for (int r = 0; r < NR; ++r) { const f32x4* xr = (const f32x4*)(xrow + (size_t)r * DM) + lane;
#pragma unroll
        for (int j = 0; j < 8; ++j) v[r][j] = xr[64 * j]; }
#pragma unroll
    for (int r = 0; r < NR; ++r) { s[r] = 0.f;
#pragma unroll
        for (int j = 0; j < 8; ++j) s[r] += (v[r][j].x * v[r][j].x + v[r][j].y * v[r][j].y) + (v[r][j].z * v[r][j].z + v[r][j].w * v[r][j].w);
        s[r] = 1.0f / sqrtf(wave_sum(s[r]) * (1.f / DM) + EPS); }
#pragma unroll
    for (int j = 0; j < 8; ++j) { const f32x4 gg = *((const f32x4*)g + lane + 64 * j);
#pragma unroll
        for (int r = 0; r < NR; ++r) { u32x2 w; w.x = cvtpk(v[r][j].x * s[r] * gg.x, v[r][j].y * s[r] * gg.y); w.y = cvtpk(v[r][j].z * s[r] * gg.z, v[r][j].w * s[r] * gg.w);
            *((u32x2*)(orow + (size_t)r * DM) + lane + 64 * j) = w;
            u32x2 c; c.x = cvtpk(v[r][j].x, v[r][j].y); c.y = cvtpk(v[r][j].z, v[r][j].w); *((u32x2*)(crow + (size_t)r * DM) + lane + 64 * j) = c; } }
}
template <int NR>
__device__ __forceinline__ void norm_rows_b(const bf16_t* xrow, const float* g, bf16_t* orow, int lane) {
    u32x4 v[NR][4]; float s[NR];
#pragma unroll
    for (int r = 0; r < NR; ++r) { const u32x4* xr = (const u32x4*)(xrow + (size_t)r * DM) + lane;
#pragma unroll
        for (int j = 0; j < 4; ++j) v[r][j] = xr[64 * j]; }
#pragma unroll
    for (int r = 0; r < NR; ++r) { s[r] = 0.f;
#pragma unroll
        for (int j = 0; j < 4; ++j)
#pragma unroll
            for (int e = 0; e < 4; ++e) { const float a = bflo(v[r][j][e]), c = bfhi(v[r][j][e]); s[r] += a * a + c * c; }
        s[r] = 1.0f / sqrtf(wave_sum(s[r]) * (1.f / DM) + EPS); }
#pragma unroll
    for (int j = 0; j < 4; ++j) { const f32x4 g0 = *((const f32x4*)g + 2 * (lane + 64 * j)), g1 = *((const f32x4*)g + 2 * (lane + 64 * j) + 1);
#pragma unroll
        for (int r = 0; r < NR; ++r) { u32x4 w;
            w.x = cvtpk(bflo(v[r][j].x) * s[r] * g0[0], bfhi(v[r][j].x) * s[r] * g0[1]); w.y = cvtpk(bflo(v[r][j].y) * s[r] * g0[2], bfhi(v[r][j].y) * s[r] * g0[3]);
            w.z = cvtpk(bflo(v[r][j].z) * s[r] * g1[0], bfhi(v[r][j].z) * s[r] * g1[1]); w.w = cvtpk(bflo(v[r][j].w) * s[r] * g1[2], bfhi(v[r][j].w) * s[r] * g1[3]);
            *((u32x4*)(orow + (size_t)r * DM) + lane + 64 * j) = w; } }
}
__device__ __forceinline__ void norm_phase(const float* x, const float* g, bf16_t* hn, bf16_t* cp, int gw, int ngw, int lane) {
#pragma unroll 1
    for (int m = gw * 2; m < M; m += ngw * 2) norm_rows<2>(x + (size_t)m * DM, g, hn + (size_t)m * DM, cp + (size_t)m * DM, lane);
}
__device__ __forceinline__ void norm_phase_b(const bf16_t* x, const float* g, bf16_t* hn, int gw, int ngw, int lane) {
#pragma unroll 1
    for (int m = gw * 2; m < M; m += ngw * 2) norm_rows_b<2>(x + (size_t)m * DM, g, hn + (size_t)m * DM, lane);
}

__device__ __forceinline__ void pool_pre_phase(const bf16_t* hn, bf16_t* yp, int gtid, int ngt) {
    for (int idx = gtid; idx < NB * (SEQ / 64) * (DM / 2); idx += ngt) {
        const int cp = idx & 1023, run = idx >> 10, col = cp * 2, g = col >> 9, w = 2 << g;
        const int tr0 = (run & 63) * 64;
        const size_t row0 = (size_t)run * 64;
        const bf16_t* p = hn + row0 * DM + col;
        float r0[16], r1[16]; float s0 = 0.f, s1 = 0.f;
#pragma unroll
        for (int i = 0; i < 16; ++i) { r0[i] = 0.f; r1[i] = 0.f; }
        if (tr0 > 0) {
#pragma unroll
            for (int i = 1; i < 16; ++i) { const unsigned v = *(const unsigned*)(p - (size_t)(16 - i) * DM); r0[i] = bflo(v); r1[i] = bfhi(v);
                if (16 - i <= w) { s0 += r0[i]; s1 += r1[i]; } }
        }
        for (int tb = 0; tb < 64; tb += 16) {
#pragma unroll
            for (int i = 0; i < 16; ++i) { const int t = tb + i; const unsigned v = *(const unsigned*)(p + (size_t)t * DM);
                const float n0 = bflo(v), n1 = bfhi(v);
                const float o0 = r0[(i + 16 - w) & 15], o1 = r1[(i + 16 - w) & 15];
                s0 += n0 - o0; s1 += n1 - o1; r0[i] = n0; r1[i] = n1;
                const int cnt = (tr0 + t + 1 < w) ? (tr0 + t + 1) : w; const float inv = 1.0f / (float)cnt;
                *(unsigned*)(yp + (row0 + t) * DM + col) = cvtpk(s0 * inv - n0, s1 * inv - n1); }
        }
    }
}

__device__ __forceinline__ void qknorm_phase(bf16_t* proj, const float* qg, const float* kg, int gw, int ngw, int lane) {
    const int sub = lane >> 4, l16 = lane & 15;
    constexpr int NIT = M * 16 / 4, U = 4;
    for (int it0 = gw * U; it0 < NIT; it0 += ngw * U) {
        u32x4 v[U]; bf16_t* p[U];
#pragma unroll
        for (int u = 0; u < U; ++u) { const int G = (it0 + u) * 4 + sub, row = G >> 4, hd = 16 + (G & 15); p[u] = proj + (size_t)row * DIFF_IN + hd * 128 + l16 * 8; v[u] = *(const u32x4*)p[u]; }
#pragma unroll
        for (int u = 0; u < U; ++u) { const int hd = 16 + (((it0 + u) * 4 + sub) & 15);
            float f[8]; float ss = 0.f;
#pragma unroll
            for (int e = 0; e < 4; ++e) { f[2 * e] = bflo(v[u][e]); f[2 * e + 1] = bfhi(v[u][e]); ss += f[2 * e] * f[2 * e] + f[2 * e + 1] * f[2 * e + 1]; }
            ss += __shfl_xor(ss, 1); ss += __shfl_xor(ss, 2); ss += __shfl_xor(ss, 4); ss += __shfl_xor(ss, 8);
            const float rs = (1.0f / sqrtf(ss * (1.f / 128.f) + EPS)) * (hd < 16 ? QSCALE : 1.0f);
            const float* gp = (hd < 16 ? qg : kg) + l16 * 8;
            const f32x4 g0 = *(const f32x4*)gp, g1 = *(const f32x4*)(gp + 4);
            u32x4 o; o.x = cvtpk(f[0] * rs * g0.x, f[1] * rs * g0.y); o.y = cvtpk(f[2] * rs * g0.z, f[3] * rs * g0.w);
            o.z = cvtpk(f[4] * rs * g1.x, f[5] * rs * g1.y); o.w = cvtpk(f[6] * rs * g1.z, f[7] * rs * g1.w);
            *(u32x4*)p[u] = o; }
    }
}

__device__ __forceinline__ void attn_phase(LAS unsigned char* lds, const bf16_t* proj, bf16_t* oa, const float* lamp, const float* subg, const float* relb, const float* qg, int wg, int tid) {
    const int lane = tid & 63, wave = __builtin_amdgcn_readfirstlane(tid >> 6), fr = lane & 15, fq = lane >> 4;
    constexpr int KP = 144, VP = 272, KB_BUF = 2 * 32 * KP, VB_BUF = 32 * VP;
    LAS bf16_t* Kb = (LAS bf16_t*)lds;
    LAS bf16_t* Vb = (LAS bf16_t*)(lds + 2 * KB_BUF * 2);
    LAS float* tb = (LAS float*)(lds + 2 * KB_BUF * 2 + 2 * VB_BUF * 2);
    LAS bf16_t* Qs = (LAS bf16_t*)(lds + 2 * KB_BUF * 2 + 2 * VB_BUF * 2 + 2048);
    float lam;
    { const float s1 = lamp[lane] * lamp[128 + lane] + lamp[64 + lane] * lamp[192 + lane];
      const float s2 = lamp[256 + lane] * lamp[384 + lane] + lamp[320 + lane] * lamp[448 + lane];
      lam = expf(wave_sum(s1)) - expf(wave_sum(s2)) + LAM_INIT; }
    const int xj = wg >> 3, bh = (wg & 7) * 4 + (xj >> 3), b = bh >> 3, h = bh & 7, sx = xj & 7;
    const size_t rb = (size_t)b * SEQ;
    const bf16_t* ksrc = proj + rb * DIFF_IN + 2048 + (2 * h) * 128;
    const bf16_t* vsrc = proj + rb * DIFF_IN + 4096 + h * 256;
    if (tid < 258) { const int sub = tid >= 129 ? 1 : 0, rel = tid - 129 * sub; int bucket;
        if (rel < 16) bucket = rel; else if (rel >= 128) bucket = 31;
        else { bucket = 16 + (int)(logf((float)rel / 16.0f) / 2.0794415416798357f * 16.0f); if (bucket > 31) bucket = 31; }
        tb[sub * 132 + rel] = relb[bucket * 16 + 2 * h + sub] * LOG2E; }
    const float c31a = relb[31 * 16 + 2 * h] * LOG2E, c31b = relb[31 * 16 + 2 * h + 1] * LOG2E;
    for (int ui = 0; ui < 4; ++ui) {
        const int qb = (ui == 0) ? sx : (ui == 1) ? 15 - sx : (ui == 2) ? 16 + sx : 31 - sx;
        const int q0 = qb * 128, qw0 = q0 + wave * 16, nkt = (q0 + 128) / 32;
        LAS bf16_t* Qw = Qs + wave * (2 * 16 * KP);
#pragma unroll
        for (int s = 0; s < 2; ++s) { u32x4 qc[4]; float ss = 0.f;
#pragma unroll
            for (int ks = 0; ks < 4; ++ks) { qc[ks] = *(const u32x4*)(proj + (rb + qw0 + fr) * DIFF_IN + (2 * h + s) * 128 + 32 * ks + 8 * fq);
#pragma unroll
                for (int e = 0; e < 4; ++e) { const float a = bflo(qc[ks][e]), c = bfhi(qc[ks][e]); ss += a * a + c * c; } }
            ss += __shfl_xor(ss, 16); ss += __shfl_xor(ss, 32);
            const float rs = (1.0f / sqrtf(ss * (1.f / 128.f) + EPS)) * QSCALE;
#pragma unroll
            for (int ks = 0; ks < 4; ++ks) { const f32x4 g0 = *(const f32x4*)(qg + 32 * ks + 8 * fq), g1 = *(const f32x4*)(qg + 32 * ks + 8 * fq + 4);
                u32x4 o; o.x = cvtpk(bflo(qc[ks].x) * rs * g0[0], bfhi(qc[ks].x) * rs * g0[1]); o.y = cvtpk(bflo(qc[ks].y) * rs * g0[2], bfhi(qc[ks].y) * rs * g0[3]);
                o.z = cvtpk(bflo(qc[ks].z) * rs * g1[0], bfhi(qc[ks].z) * rs * g1[1]); o.w = cvtpk(bflo(qc[ks].w) * rs * g1[2], bfhi(qc[ks].w) * rs * g1[3]);
                *(LAS u32x4*)(Qw + (s * 16 + fr) * KP + 32 * ks + 8 * fq) = o; } }
#pragma unroll
        for (int i = 0; i < 2; ++i) { const int id = tid + 512 * i, s = id >> 9, row = (id >> 4) & 31, ch = id & 15;
            *(LAS u32x4*)(Kb + (s * 32 + row) * KP + ch * 8) = *(const u32x4*)(ksrc + (size_t)row * DIFF_IN + s * 128 + ch * 8); }
#pragma unroll
        for (int i = 0; i < 2; ++i) { const int id = tid + 512 * i, row = id >> 5, ch = id & 31;
            *(LAS u32x4*)(Vb + row * VP + ch * 8) = *(const u32x4*)(vsrc + (size_t)row * DIFF_IN + ch * 8); }
        __syncthreads();
        float l0 = 0.f, l1 = 0.f;
        f32x4 o[2][16];
#pragma unroll
        for (int s = 0; s < 2; ++s)
#pragma unroll
            for (int vt = 0; vt < 16; ++vt) o[s][vt] = (f32x4){0.f, 0.f, 0.f, 0.f};
        for (int kt = 0; kt < nkt; ++kt) {
            const int cur = kt & 1, k0 = kt * 32; const bool more = kt + 1 < nkt;
            u32x4 kr[2], vr[2];
            if (more) {
#pragma unroll
                for (int i = 0; i < 2; ++i) { const int id = tid + 512 * i, s = id >> 9, row = (id >> 4) & 31, ch = id & 15; kr[i] = *(const u32x4*)(ksrc + (size_t)(k0 + 32 + row) * DIFF_IN + s * 128 + ch * 8); }
#pragma unroll
                for (int i = 0; i < 2; ++i) { const int id = tid + 512 * i, row = id >> 5, ch = id & 31; vr[i] = *(const u32x4*)(vsrc + (size_t)(k0 + 32 + row) * DIFF_IN + ch * 8); }
            }
            if (k0 <= qw0 + 15) {
                const LAS bf16_t* Kc = Kb + cur * KB_BUF; const LAS bf16_t* Vc = Vb + cur * VB_BUF;
                const bool far = (qw0 - (k0 + 31)) >= 128;
                f32x4 st[2][2];
                int qoff = (fr * KP + 8 * fq); asm volatile("" : "+v"(qoff));
#pragma unroll
                for (int s = 0; s < 2; ++s) { const float ini = far ? (s ? c31b : c31a) : 0.f;
                    st[s][0] = (f32x4){ini, ini, ini, ini}; st[s][1] = st[s][0];
#pragma unroll
                    for (int ks = 0; ks < 4; ++ks) { const bf16x8 qfr = *(const LAS bf16x8*)(Qw + s * 16 * KP + qoff + 32 * ks);
#pragma unroll
                        for (int T = 0; T < 2; ++T) st[s][T] = mma16(frag_rowk(Kc + s * 32 * KP, KP, 16 * T, 32 * ks, fr, fq), qfr, st[s][T]); } }
                if (!far) {
#pragma unroll
                    for (int T = 0; T < 2; ++T)
#pragma unroll
                        for (int r = 0; r < 4; ++r) { const int rel = qw0 + fr - (k0 + 16 * T + 4 * fq + r); const int ri = rel < 0 ? 0 : (rel > 128 ? 128 : rel);
                            const float b0 = tb[ri], b1 = tb[132 + ri];
                            st[0][T][r] = rel < 0 ? -INFINITY : st[0][T][r] + b0; st[1][T][r] = rel < 0 ? -INFINITY : st[1][T][r] + b1; }
                }
                bf16x8 pf[2];
#pragma unroll
                for (int s = 0; s < 2; ++s) { float ps = 0.f;
#pragma unroll
                    for (int T = 0; T < 2; ++T)
#pragma unroll
                        for (int r = 0; r < 4; ++r) { const float p = __builtin_amdgcn_exp2f(st[s][T][r]); st[s][T][r] = p; ps += p; }
                    if (s == 0) l0 += ps; else l1 += ps;
                    u32x4 w; w.x = cvtpk(st[s][0][0], st[s][0][1]); w.y = cvtpk(st[s][0][2], st[s][0][3]); w.z = cvtpk(st[s][1][0], st[s][1][1]); w.w = cvtpk(st[s][1][2], st[s][1][3]);
                    pf[s] = __builtin_bit_cast(bf16x8, w); }
                __builtin_amdgcn_s_setprio(1);
#pragma unroll
                for (int vt = 0; vt < 16; ++vt) { const bf16x8 vf = frag_tr2(Vc, VP, 4 * fq, 16 + 4 * fq, 16 * vt, fr);
                    o[0][vt] = mma16(vf, pf[0], o[0][vt]); o[1][vt] = mma16(vf, pf[1], o[1][vt]); }
                __builtin_amdgcn_s_setprio(0);
            }
            if (more) {
                LAS bf16_t* Kn = Kb + (cur ^ 1) * KB_BUF; LAS bf16_t* Vn = Vb + (cur ^ 1) * VB_BUF;
#pragma unroll
                for (int i = 0; i < 2; ++i) { const int id = tid + 512 * i, s = id >> 9, row = (id >> 4) & 31, ch = id & 15; *(LAS u32x4*)(Kn + (s * 32 + row) * KP + ch * 8) = kr[i]; }
#pragma unroll
                for (int i = 0; i < 2; ++i) { const int id = tid + 512 * i, row = id >> 5, ch = id & 31; *(LAS u32x4*)(Vn + row * VP + ch * 8) = vr[i]; }
            }
            __syncthreads();
        }
        l0 += __shfl_xor(l0, 16); l0 += __shfl_xor(l0, 32); l1 += __shfl_xor(l1, 16); l1 += __shfl_xor(l1, 32);
        const float i0 = 1.0f / l0, i1 = lam / l1; float ss = 0.f;
#pragma unroll
        for (int vt = 0; vt < 16; ++vt) { o[0][vt] = o[0][vt] * i0 - o[1][vt] * i1; const f32x4 a = o[0][vt]; ss += (a[0] * a[0] + a[1] * a[1]) + (a[2] * a[2] + a[3] * a[3]); }
        ss += __shfl_xor(ss, 16); ss += __shfl_xor(ss, 32);
        const float rs = (1.0f / sqrtf(ss * (1.f / 256.f) + EPS)) * (1.0f - LAM_INIT);
        {   LAS bf16_t* Ow = Qw;
#pragma unroll
            for (int vt = 0; vt < 16; ++vt) { const f32x4 g = *(const f32x4*)(subg + 16 * vt + 4 * fq);
                u32x2 w; w.x = cvtpk(o[0][vt][0] * rs * g[0], o[0][vt][1] * rs * g[1]); w.y = cvtpk(o[0][vt][2] * rs * g[2], o[0][vt][3] * rs * g[3]);
                *(LAS u32x2*)(Ow + fr * 264 + 16 * vt + 4 * fq) = w; }
            asm volatile("s_waitcnt lgkmcnt(0)" ::: "memory");
#pragma unroll
            for (int i = 0; i < 8; ++i) { const int row = 2 * i + (lane >> 5), ch = lane & 31;
                const u32x4 v = *(const LAS u32x4*)(Ow + row * 264 + ch * 8);
                *(u32x4*)(oa + (rb + qw0 + row) * DM + h * 256 + ch * 8) = v; }
            asm volatile("s_waitcnt lgkmcnt(0)" ::: "memory"); }
    }
}

__device__ __forceinline__ unsigned short f2bf1(float x) { return (unsigned short)(cvtpk(x, 0.f) & 0xffffu); }
__device__ __forceinline__ void gla_pre_phase(LAS unsigned char* lds, const bf16_t* proj, const bf16_t* hn, const bf16_t* wlr, const float* wa2, const float* ba, bf16_t* QT, bf16_t* KT, bf16_t* KH, float* DEC, int wg, int nwg, int tid) {
    LAS float* alr = (LAS float*)lds;
    LAS float* tot = alr + 1024;
    LAS float* bl = tot + 256;
    LAS float* bbL = bl + 256;
    constexpr int BP = 260;
    const int d = tid & 255, half = tid >> 8;
    const int lane = tid & 63, wave = __builtin_amdgcn_readfirstlane(tid >> 6), fr = lane & 15, fq = lane >> 4;
    LAS float* part = bbL;
    for (int bc = wg; bc < NB * GLA_NC; bc += nwg) {
      const size_t t0 = (size_t)bc * 64;
      {
          const int tt = wave & 3, kh = wave >> 2;
          const bf16_t* ap = hn + (t0 + 16 * tt + fr) * DM + kh * 1024 + 8 * fq;
          const bf16_t* bp = wlr + (size_t)fr * DM + kh * 1024 + 8 * fq;
          f32x4 acc = (f32x4){0.f, 0.f, 0.f, 0.f};
#pragma unroll 8
          for (int ks = 0; ks < 32; ++ks) acc = mma16(*(const bf16x8*)(ap + 32 * ks), *(const bf16x8*)(bp + 32 * ks), acc);
          if (kh == 1) *(LAS f32x4*)(part + (tt * 64 + lane) * 4) = acc;
          __syncthreads();
          if (kh == 0) { const f32x4 o = acc + *(const LAS f32x4*)(part + (tt * 64 + lane) * 4);
#pragma unroll
              for (int rr = 0; rr < 4; ++rr) alr[(16 * tt + 4 * fq + rr) * 16 + fr] = o[rr]; }
          __syncthreads();
      }
      for (int h = 0; h < GLA_H; ++h) {
        float w[16];
#pragma unroll
        for (int r = 0; r < 16; ++r) w[r] = wa2[r * GLA_DK + h * 256 + d];
        const float bias = ba[h * 256 + d];
        __syncthreads();
        float cum = 0.f;
#pragma unroll 8
        for (int i = 0; i < 32; ++i) { const int t = half * 32 + i; float z = bias;
            const LAS f32x4* ap = (const LAS f32x4*)(alr + t * 16);
#pragma unroll
            for (int r4 = 0; r4 < 4; ++r4) { const f32x4 av = ap[r4]; z += av[0] * w[4 * r4] + av[1] * w[4 * r4 + 1] + av[2] * w[4 * r4 + 2] + av[3] * w[4 * r4 + 3]; }
            const float la = (fminf(z, 0.f) - __logf(1.0f + __expf(-fabsf(z)))) * (1.0f / 16.0f);
            cum += la; bbL[t * BP + d] = cum; }
        if (half == 0) tot[d] = cum;
        __syncthreads();
        if (half == 1) { const float blv = cum + tot[d]; bl[d] = blv; DEC[(size_t)bc * GLA_DK + h * 256 + d] = __expf(blv); }
        __syncthreads();
#pragma unroll
        for (int i = 0; i < 4; ++i) { const int id = tid + 512 * i, t = id >> 5, dg = (id & 31) * 8;
            const size_t row = t0 + t;
            const u32x4 qv = *(const u32x4*)(proj + row * GLA_PP + h * 256 + dg), kv = *(const u32x4*)(proj + row * GLA_PP + 1024 + h * 256 + dg);
            u32x4 oq, oh;
#pragma unroll
            for (int e = 0; e < 4; ++e) {
                float b0 = bbL[t * BP + dg + 2 * e], b1 = bbL[t * BP + dg + 2 * e + 1];
                if (t >= 32) { b0 += tot[dg + 2 * e]; b1 += tot[dg + 2 * e + 1]; }
                const float l0 = bl[dg + 2 * e], l1 = bl[dg + 2 * e + 1];
                const float q0 = bflo(qv[e]), q1 = bfhi(qv[e]), k0 = bflo(kv[e]), k1 = bfhi(kv[e]);
                oq[e] = cvtpk(q0 * __expf(b0) * (1.0f / 16.0f), q1 * __expf(b1) * (1.0f / 16.0f));
                oh[e] = cvtpk(k0 * __expf(l0 - b0), k1 * __expf(l1 - b1)); }
            const size_t oidx = row * GLA_DK + h * 256 + dg;
            *(u32x4*)(QT + oidx) = oq; *(u32x4*)(KH + oidx) = oh; }
        __syncthreads();
      }
    }
}

__device__ __forceinline__ void gla_seq_phase(LAS unsigned char* lds, const bf16_t* QT, const bf16_t* KH, const bf16_t* proj, const float* DEC, bf16_t* OI, int wg, int nwg, int tid) {
    const int lane = tid & 63, wave = __builtin_amdgcn_readfirstlane(tid >> 6), fr = lane & 15, fq = lane >> 4;
    constexpr int QP = 272, KHP = 272, VP = 48;
    LAS bf16_t* Qt = (LAS bf16_t*)lds;
    LAS bf16_t* Kh = (LAS bf16_t*)(lds + 34816);
    LAS bf16_t* Vt = (LAS bf16_t*)(lds + 69632);
    LAS float* dec = (LAS float*)(lds + 75776);
    LAS bf16_t* SBt = (LAS bf16_t*)(lds + 76800);
    LAS bf16_t* Ost = (LAS bf16_t*)(lds + 111616);
    for (int u = wg; u < 256; u += nwg) {
        const int uj = u >> 3, ubh = (u & 7) * 2 + (uj >> 4), vs = uj & 15, h = ubh & 3, b = ubh >> 2;
        const size_t tb0 = (size_t)b * SEQ;
        const bf16_t* qsrc = QT + tb0 * GLA_DK + h * 256;
        const bf16_t* ksrc = KH + tb0 * GLA_DK + h * 256;
        const bf16_t* vsrc = proj + tb0 * GLA_PP + 2048 + h * 512 + vs * 32;
        const float* dsrc = DEC + (size_t)b * GLA_NC * GLA_DK + h * 256;
        for (int i = tid; i < 32 * QP / 2; i += NTHR) ((LAS unsigned*)SBt)[i] = 0u;
        f32x4 S[2][2];
#pragma unroll
        for (int a = 0; a < 2; ++a)
#pragma unroll
            for (int c = 0; c < 2; ++c) S[a][c] = (f32x4){0.f, 0.f, 0.f, 0.f};
        u32x4 qr[4], kr[4], vr, dr;
        vr = (u32x4){0u, 0u, 0u, 0u}; dr = vr;
#define GLA_SEQ_LOAD(c) do { \
            _Pragma("unroll") for (int i = 0; i < 4; ++i) { const int id = tid + 512 * i, row = id >> 5, ch = id & 31; \
                qr[i] = *(const u32x4*)(qsrc + (size_t)((c) * 64 + row) * GLA_DK + ch * 8); kr[i] = *(const u32x4*)(ksrc + (size_t)((c) * 64 + row) * GLA_DK + ch * 8); } \
            if (tid < 256) { const int row = tid >> 2, ch = tid & 3; vr = *(const u32x4*)(vsrc + (size_t)((c) * 64 + row) * GLA_PP + ch * 8); } \
            else if (tid < 320) { dr = *(const u32x4*)(dsrc + (size_t)(c) * GLA_DK + (tid - 256) * 4); } } while (0)
#define GLA_SEQ_STORE() do { \
            _Pragma("unroll") for (int i = 0; i < 4; ++i) { const int id = tid + 512 * i, row = id >> 5, ch = id & 31; \
                *(LAS u32x4*)(Qt + row * QP + ch * 8) = qr[i]; *(LAS u32x4*)(Kh + row * KHP + ch * 8) = kr[i]; } \
            if (tid < 256) { const int row = tid >> 2, ch = tid & 3; *(LAS u32x4*)(Vt + row * VP + ch * 8) = vr; } \
            else if (tid < 320) { *(LAS u32x4*)(dec + (tid - 256) * 4) = dr; } } while (0)
        GLA_SEQ_LOAD(0);
        GLA_SEQ_STORE();
        __syncthreads();
        for (int c = 0; c < GLA_NC; ++c) {
            const int cur = c & 1;
            if (c + 1 < GLA_NC) GLA_SEQ_LOAD(c + 1);
            const LAS bf16_t* Sc = SBt + cur * 32 * QP; LAS bf16_t* Sn = SBt + (cur ^ 1) * 32 * QP;
            {
                const int vt = wave & 1, tt = wave >> 1; f32x4 acc = (f32x4){0.f, 0.f, 0.f, 0.f};
#pragma unroll
                for (int ks = 0; ks < 8; ++ks) acc = mma16(frag_rowk(Sc, QP, 16 * vt, 32 * ks, fr, fq), frag_rowk(Qt, QP, 16 * tt, 32 * ks, fr, fq), acc);
                { u32x2 w; w.x = cvtpk(acc[0], acc[1]); w.y = cvtpk(acc[2], acc[3]); *(LAS u32x2*)(Ost + (16 * tt + fr) * 32 + 16 * vt + 4 * fq) = w; }
            }
#pragma unroll
            for (int dl = 0; dl < 2; ++dl) { const f32x4 d4 = *(const LAS f32x4*)(dec + 16 * (2 * wave + dl) + 4 * fq);
#pragma unroll
                for (int vt = 0; vt < 2; ++vt) S[dl][vt] = S[dl][vt] * d4; }
#pragma unroll
            for (int ks = 0; ks < 2; ++ks) {
                bf16x8 bfr[2];
#pragma unroll
                for (int vt = 0; vt < 2; ++vt) bfr[vt] = frag_tr2(Vt, VP, 32 * ks + 4 * fq, 32 * ks + 16 + 4 * fq, 16 * vt, fr);
#pragma unroll
                for (int dl = 0; dl < 2; ++dl) { const bf16x8 af = frag_tr2(Kh, KHP, 32 * ks + 4 * fq, 32 * ks + 16 + 4 * fq, 16 * (2 * wave + dl), fr);
#pragma unroll
                    for (int vt = 0; vt < 2; ++vt) S[dl][vt] = mma16(af, bfr[vt], S[dl][vt]); }
            }
#pragma unroll
            for (int dl = 0; dl < 2; ++dl)
#pragma unroll
                for (int vt = 0; vt < 2; ++vt) { u32x2 w; w.x = cvtpk(S[dl][vt][0], S[dl][vt][1]); w.y = cvtpk(S[dl][vt][2], S[dl][vt][3]);
                    *(LAS u32x2*)(Sn + (16 * vt + fr) * QP + 16 * (2 * wave + dl) + 4 * fq) = w; }
            __syncthreads();
            if (c + 1 < GLA_NC) GLA_SEQ_STORE();
            if (tid < 256) *(u32x4*)(OI + ((((tb0 >> 6) + c) * 4 + h) * 16 + vs) * 2048 + tid * 8) = *(const LAS u32x4*)(Ost + tid * 8);
            __syncthreads();
        }
#undef GLA_SEQ_LOAD
#undef GLA_SEQ_STORE
    }
}

__device__ __forceinline__ void gla_post_phase(LAS unsigned char* lds, const bf16_t* QT, const bf16_t* KT  , const float* DEC, const bf16_t* proj, const bf16_t* OI, const float* gnorm, bf16_t* OG, int wg, int nwg, int tid) {
    const int lane = tid & 63, wave = __builtin_amdgcn_readfirstlane(tid >> 6), fr = lane & 15, fq = lane >> 4;
    constexpr int QP = 272, PP = 80, VP = 528;
    LAS bf16_t* Qt = (LAS bf16_t*)lds;
    LAS bf16_t* Kt = (LAS bf16_t*)(lds + 34816);
    LAS bf16_t* P = (LAS bf16_t*)(lds + 69632);
    LAS bf16_t* V = (LAS bf16_t*)(lds + 79872);
    LAS float* red = (LAS float*)(lds + 147456);
    for (int u = wg; u < NB * GLA_NC * GLA_H; u += nwg) {
        const int h = u & 3, bc = u >> 2; const size_t t0 = (size_t)bc * 64;
        float idc[8];
        { const float* dp = DEC + (size_t)bc * GLA_DK + h * 256 + (tid & 31) * 8; const f32x4 d0 = *(const f32x4*)dp, d1 = *(const f32x4*)(dp + 4);
          idc[0] = 1.0f / d0[0]; idc[1] = 1.0f / d0[1]; idc[2] = 1.0f / d0[2]; idc[3] = 1.0f / d0[3]; idc[4] = 1.0f / d1[0]; idc[5] = 1.0f / d1[1]; idc[6] = 1.0f / d1[2]; idc[7] = 1.0f / d1[3]; }
#pragma unroll
        for (int i = 0; i < 4; ++i) { const int id = tid + 512 * i, row = id >> 5, ch = id & 31;
            const u32x4 qv = *(const u32x4*)(QT + (t0 + row) * GLA_DK + h * 256 + ch * 8);
            u32x4 qs; qs.x = cvtpk(bflo(qv.x) * idc[0], bfhi(qv.x) * idc[1]); qs.y = cvtpk(bflo(qv.y) * idc[2], bfhi(qv.y) * idc[3]);
            qs.z = cvtpk(bflo(qv.z) * idc[4], bfhi(qv.z) * idc[5]); qs.w = cvtpk(bflo(qv.w) * idc[6], bfhi(qv.w) * idc[7]);
            *(LAS u32x4*)(Qt + row * QP + ch * 8) = qs;
            *(LAS u32x4*)(Kt + row * QP + ch * 8) = *(const u32x4*)(KT + (t0 + row) * GLA_DK + h * 256 + ch * 8); }
#pragma unroll
        for (int i = 0; i < 8; ++i) { const int id = tid + 512 * i, row = id >> 6, ch = id & 63;
            *(LAS u32x4*)(V + row * VP + ch * 8) = *(const u32x4*)(proj + (t0 + row) * GLA_PP + 2048 + h * 512 + ch * 8); }
        __syncthreads();
        {
            const int st_ = wave >> 1;
#pragma unroll
            for (int e = 0; e < 2; ++e) { const int tt = 2 * (wave & 1) + e; f32x4 acc = (f32x4){0.f, 0.f, 0.f, 0.f};
#pragma unroll
                for (int ks = 0; ks < 8; ++ks) acc = mma16(frag_rowk(Kt, QP, 16 * st_, 32 * ks, fr, fq), frag_rowk(Qt, QP, 16 * tt, 32 * ks, fr, fq), acc);
                const int t = 16 * tt + fr, s0 = 16 * st_ + 4 * fq;
                u32x2 w; w.x = cvtpk(s0 <= t ? acc[0] : 0.f, s0 + 1 <= t ? acc[1] : 0.f); w.y = cvtpk(s0 + 2 <= t ? acc[2] : 0.f, s0 + 3 <= t ? acc[3] : 0.f);
                *(LAS u32x2*)(P + t * PP + 32 * (st_ >> 1) + 8 * fq + 4 * (st_ & 1)) = w; }
        }
        __syncthreads();
        f32x4 acc[4][4];
#pragma unroll
        for (int vt = 0; vt < 4; ++vt)
#pragma unroll
            for (int tt = 0; tt < 4; ++tt) acc[vt][tt] = (f32x4){0.f, 0.f, 0.f, 0.f};
#pragma unroll
        for (int ks = 0; ks < 2; ++ks) {
            bf16x8 pb[4];
#pragma unroll
            for (int tt = 0; tt < 4; ++tt) pb[tt] = frag_rowk(P, PP, 16 * tt, 32 * ks, fr, fq);
#pragma unroll
            for (int vt = 0; vt < 4; ++vt) { const int cb = 64 * wave + 32 * (vt >> 1) + 8 * (fr & 3) + 4 * (vt & 1);
                const LAS bf16_t* pa = V + (32 * ks + 4 * fq + (fr >> 2)) * VP + cb;
                const s16x4 ta = __builtin_amdgcn_ds_read_tr16_b64_v4i16((LAS s16x4*)pa), tb2 = __builtin_amdgcn_ds_read_tr16_b64_v4i16((LAS s16x4*)(pa + 16 * VP));
                const bf16x8 af = (bf16x8){ta[0], ta[1], ta[2], ta[3], tb2[0], tb2[1], tb2[2], tb2[3]};
#pragma unroll
                for (int tt = 0; tt < 4; ++tt) acc[vt][tt] = mma16(af, pb[tt], acc[vt][tt]); }
        }
        float ss[4];
#pragma unroll
        for (int tt = 0; tt < 4; ++tt) { ss[tt] = 0.f;
#pragma unroll
            for (int P2 = 0; P2 < 2; ++P2) { const u32x4 oiw = *(const u32x4*)(OI + (((size_t)bc * 4 + h) * 16 + 2 * wave + P2) * 2048 + (16 * tt + fr) * 32 + 8 * fq);
                const f32x4 o0 = (f32x4){bflo(oiw.x), bfhi(oiw.x), bflo(oiw.y), bfhi(oiw.y)}, o1 = (f32x4){bflo(oiw.z), bfhi(oiw.z), bflo(oiw.w), bfhi(oiw.w)};
                acc[2 * P2][tt] = acc[2 * P2][tt] + o0; acc[2 * P2 + 1][tt] = acc[2 * P2 + 1][tt] + o1;
                const f32x4 a = acc[2 * P2][tt], c = acc[2 * P2 + 1][tt];
                ss[tt] += ((a[0] * a[0] + a[1] * a[1]) + (a[2] * a[2] + a[3] * a[3])) + ((c[0] * c[0] + c[1] * c[1]) + (c[2] * c[2] + c[3] * c[3])); }
            ss[tt] += __shfl_xor(ss[tt], 16); ss[tt] += __shfl_xor(ss[tt], 32);
            if (fq == 0) red[(16 * tt + fr) * 8 + wave] = ss[tt]; }
        __syncthreads();
#pragma unroll
        for (int tt = 0; tt < 4; ++tt) { const LAS f32x4* rp = (const LAS f32x4*)(red + (16 * tt + fr) * 8); const f32x4 r0 = rp[0], r1 = rp[1];
            const float tot = ((r0[0] + r0[1]) + (r0[2] + r0[3])) + ((r1[0] + r1[1]) + (r1[2] + r1[3]));
            const float rs = 1.0f / sqrtf(tot * (1.f / 512.f) + EPS); const size_t row = t0 + 16 * tt + fr;
#pragma unroll
            for (int P2 = 0; P2 < 2; ++P2) { const int v = 64 * wave + 32 * P2 + 8 * fq;
                const u32x4 rr = *(const u32x4*)(proj + row * GLA_PP + 4096 + h * 512 + v); const f32x4 g0 = *(const f32x4*)(gnorm + v), g1 = *(const f32x4*)(gnorm + v + 4);
                const f32x4 a = acc[2 * P2][tt], c = acc[2 * P2 + 1][tt];
                u32x4 w; w.x = cvtpk(a[0] * rs * g0[0] * pg8::silu_f(bflo(rr.x)), a[1] * rs * g0[1] * pg8::silu_f(bfhi(rr.x)));
                w.y = cvtpk(a[2] * rs * g0[2] * pg8::silu_f(bflo(rr.y)), a[3] * rs * g0[3] * pg8::silu_f(bfhi(rr.y)));
                w.z = cvtpk(c[0] * rs * g1[0] * pg8::silu_f(bflo(rr.z)), c[1] * rs * g1[1] * pg8::silu_f(bfhi(rr.z)));
                w.w = cvtpk(c[2] * rs * g1[2] * pg8::silu_f(bflo(rr.w)), c[3] * rs * g1[3] * pg8::silu_f(bfhi(rr.w)));
                *(u32x4*)(OG + row * DM + h * 512 + v) = w; } }
        __syncthreads();
    }
}

#define XB_TMO      128
#define XB_XCNT(j)  (256  + 64 * (j))
#define XB_XSUB(j)  (1280 + 64 * (j))
#define XB_XGEN(j)  (2304 + 64 * (j))
#define XB_TOP      3328
#define XB_TOPGEN   3392
#define XCD_BAR_WORDS 3456
#define XB_SPIN_CAP (1u << 18)

__device__ __forceinline__ unsigned xb_ld(unsigned* p)              { return __hip_atomic_load(p, __ATOMIC_RELAXED, __HIP_MEMORY_SCOPE_AGENT); }
__device__ __forceinline__ unsigned xb_add(unsigned* p, unsigned v) { return __hip_atomic_fetch_add(p, v, __ATOMIC_RELAXED, __HIP_MEMORY_SCOPE_AGENT); }
__device__ __forceinline__ unsigned xb_xcc_id() { return (unsigned)__builtin_amdgcn_s_getreg((3 << 11) | 20) & 0xFu; }
#define XB_SPIN(cond, bar) do { unsigned _sp = 0; while (cond) { __builtin_amdgcn_s_sleep(1); \
    if ((++_sp & 255u) == 0u) { if (xb_ld(&(bar)[XB_TMO])) break; if (_sp > XB_SPIN_CAP) { atomicAdd(&(bar)[XB_TMO], 1u); break; } } } } while (0)

struct XcdBarrier {
    unsigned* bar; unsigned x;
    volatile LAS unsigned* st;
};

__device__ __forceinline__ XcdBarrier xcd_barrier_post(unsigned* bar, volatile LAS unsigned* st) {
    XcdBarrier b; b.bar = bar; b.x = xb_xcc_id(); b.st = st;
    if (threadIdx.x == 0) (void)xb_add(&bar[XB_XCNT(b.x)], 1u);
    return b;
}
__device__ __forceinline__ void xcd_barrier_complete(unsigned* bar, unsigned x, unsigned& nloc, unsigned& nx) {
    const unsigned G = gridDim.x * gridDim.y * gridDim.z;
    unsigned sum, cnt, mine, sp = 0u;
    for (;;) {
        sum = 0u; cnt = 0u; mine = 0u;
#pragma unroll
        for (unsigned j = 0; j < 16; ++j) { const unsigned c = xb_ld(&bar[XB_XCNT(j)]); sum += c; cnt += (c > 0u) ? 1u : 0u; mine = (j == x) ? c : mine; }
        if (sum == G) break;
        __builtin_amdgcn_s_sleep(1);
        if ((++sp & 255u) == 0u) { if (xb_ld(&bar[XB_TMO])) break; if (sp > XB_SPIN_CAP) { atomicAdd(&bar[XB_TMO], 1u); break; } }
    }
    nloc = mine > 0u ? mine : 1u; nx = cnt > 0u ? cnt : 1u;
}

__device__ __forceinline__ void xcd_barrier(const XcdBarrier& b) {
    asm volatile("s_waitcnt vmcnt(0)" ::: "memory");
    __syncthreads();
    if (threadIdx.x == 0) {
        unsigned* bar = b.bar;
        __builtin_amdgcn_s_waitcnt(0);
        unsigned nloc = b.st[0], nx = b.st[1];
        if (nloc == 0u) { xcd_barrier_complete(bar, b.x, nloc, nx); b.st[0] = nloc; b.st[1] = nx; }
        const unsigned old = xb_add(&bar[XB_XSUB(b.x)], 1u);
        const unsigned gen = old / nloc;
        if (old + 1u == (gen + 1u) * nloc) {
            __builtin_amdgcn_fence(__ATOMIC_RELEASE, "agent");
            asm volatile("s_waitcnt vmcnt(0)" ::: "memory");
            const unsigned og = xb_add(&bar[XB_TOP], 1u);
            const unsigned tg = og / nx;
            if (og + 1u == (tg + 1u) * nx) xb_add(&bar[XB_TOPGEN], 1u);
            else XB_SPIN(xb_ld(&bar[XB_TOPGEN]) == tg, bar);
            __builtin_amdgcn_fence(__ATOMIC_ACQUIRE, "agent");
            xb_add(&bar[XB_XGEN(b.x)], 1u);
            asm volatile("s_waitcnt vmcnt(0)" ::: "memory");
        } else {
            XB_SPIN(xb_ld(&bar[XB_XGEN(b.x)]) == gen, bar);
            __builtin_amdgcn_fence(__ATOMIC_ACQUIRE, "agent");
            asm volatile("s_waitcnt vmcnt(0)" ::: "memory");
        }
    }
    __syncthreads();
}

#ifndef PMASK
#define PMASK 0xFFFF
#endif
#define PON(k) ((PMASK >> (k)) & 1)
#ifndef RMASK
#define RMASK 0
#endif
#define RPT(k) (((RMASK >> (k)) & 1) ? 2 : 1)
#define REP(k, body) for (int rp_ = 0; rp_ < RPT(k); ++rp_) { body; if (rp_ + 1 < RPT(k)) GSYNC(); }
__global__ void __launch_bounds__(NTHR) mega_fwd(Args a) {
    extern __shared__ __attribute__((aligned(16))) unsigned char lds_raw[];
    cg::grid_group grid = cg::this_grid();
    LAS unsigned char* lds = (LAS unsigned char*)lds_raw;
    const int G = gridDim.x, wg = blockIdx.x;
    const int ngw = G * NWAVES, ngt = G * NTHR;
    unsigned char* ws = a.ws;
    const float* x_in = a.in[0]; const float* norm_g = a.in[1];
    float* X = a.out;
    bf16_t* W_GLA_IN = (bf16_t*)(ws + WS_GLA_IN); bf16_t* W_GLA_OUT = (bf16_t*)(ws + WS_GLA_OUT); bf16_t* W_POOL = (bf16_t*)(ws + WS_POOL);
    bf16_t* W_DIFF_IN = (bf16_t*)(ws + WS_DIFF_IN); bf16_t* W_DIFF_OUT = (bf16_t*)(ws + WS_DIFF_OUT); bf16_t* W_GU = (bf16_t*)(ws + WS_GU); bf16_t* W_DOWN = (bf16_t*)(ws + WS_DOWN);
    bf16_t* HN = (bf16_t*)(ws + WS_HN); bf16_t* PROJ = (bf16_t*)(ws + WS_PROJ); bf16_t* HID = (bf16_t*)(ws + WS_HID);
    bf16_t* QT = (bf16_t*)(ws + WS_QT); bf16_t* KT = (bf16_t*)(ws + WS_KT); bf16_t* KH = (bf16_t*)(ws + WS_KH);
    bf16_t* XB = (bf16_t*)(ws + WS_XB); float* DEC = (float*)(ws + WS_DEC); bf16_t* OI = (bf16_t*)(ws + WS_OI); bf16_t* OG = (bf16_t*)(ws + WS_OG);
    const int lo = a.lo, hi = a.hi; int seam = 0; bool final_phase = false;
    volatile LAS unsigned* MISC = (volatile LAS unsigned*)(lds + MISC_OFF);
    if (threadIdx.x < 16) MISC[threadIdx.x] = 0u;
    __syncthreads();
    const XcdBarrier xbar = xcd_barrier_post((unsigned*)(ws + WS_BAR), MISC);
#define PH_BEGIN if (seam >= lo && seam < hi) { int tid = threadIdx.x; asm volatile("" : "+v"(tid)); const int lane = tid & 63, wave = __builtin_amdgcn_readfirstlane(tid >> 6); const int gw = wg * NWAVES + wave, gtid = wg * NTHR + tid; (void)lane; (void)gw; (void)gtid;
#define GSYNC() do { if (lo < 0) grid.sync(); xcd_barrier(xbar); } while (0)
#define PH_END   if (seam + 1 < hi && !final_phase) GSYNC(); } ++seam;

    PH_BEGIN
#if PON(0)
        for (int rp0 = 0; rp0 < RPT(0); ++rp0) {
        LAS float* scr = (LAS float*)(lds + wave * 17408);
        for (int s = 0; s < 2; ++s) {
            conv_matrix(a.in[2] + (size_t)s * DM * GLA_IN, DM, GLA_IN, GLA_INP, W_GLA_IN + (size_t)s * GLA_INP * DM, 0, scr, gw, ngw, lane);
            conv_matrix(a.in[6] + (size_t)s * DM * DM, DM, DM, DM, W_GLA_OUT + (size_t)s * DM * DM, 0, scr, gw, ngw, lane);
        }
        for (int g = 0; g < 4; ++g) conv_matrix(a.in[7] + (size_t)g * 512 * 512, 512, 512, 512, W_POOL + (size_t)g * 512 * 512, 0, scr, gw, ngw, lane, a.in[8] + g * 512);
        conv_matrix(a.in[9], DM, DIFF_IN, DIFF_IN, W_DIFF_IN, 0, scr, gw, ngw, lane);
        conv_matrix(a.in[14], DM, DM, DM, W_DIFF_OUT, 0, scr, gw, ngw, lane);
        for (int l = 0; l < 4; ++l) {
            conv_matrix(a.in[16] + (size_t)l * DM * 2 * FF, DM, 2 * FF, 2 * FF, W_GU + (size_t)l * 2 * FF * DM, 1, scr, gw, ngw, lane);
            conv_matrix(a.in[17] + (size_t)l * FF * DM, FF, DM, DM, W_DOWN + (size_t)l * DM * FF, 0, scr, gw, ngw, lane);
        }
        norm_phase(x_in, norm_g, HN, XB, gw, ngw, lane);
        if (rp0 + 1 < RPT(0)) grid.sync(); }
#endif
    PH_END

    for (int layer = 0; layer < 4; ++layer) {
        const int kind = layer % 3, slot = layer / 3;
        if (kind != 1) {
            PH_BEGIN
                const int N = (kind == 0) ? GLA_PP : DIFF_IN;
                pg8::Gemm g{HN, (kind == 0) ? W_GLA_IN + (size_t)slot * GLA_INP * DM : W_DIFF_IN, M, N, DM, DM, 0};
                pg8::StaticOrder S; S.init(M, N, G, wg);
                pg8::EpiStore E{PROJ, N};
#if PON(1)
                REP(1, (pg8::gemm_phase<pg8::EpiStore, pg8::StaticOrder, true, true>(lds, g, S, E)))
#endif
            PH_END
        }
        if (kind == 0) {
#if PON(2)
            PH_BEGIN REP(2, gla_pre_phase(lds, PROJ, HN, W_GLA_IN + (size_t)slot * GLA_INP * DM + (size_t)6144 * DM, a.in[3] + (size_t)slot * GLA_RANK * GLA_DK, a.in[4] + (size_t)slot * GLA_DK, QT, KT, KH, DEC, wg, G, tid)) PH_END
#endif
#if PON(3)
            PH_BEGIN REP(3, gla_seq_phase(lds, QT, KH, PROJ, DEC, OI, wg, G, tid)) PH_END
#endif
#if PON(4)
            PH_BEGIN REP(4, gla_post_phase(lds, QT, KH, DEC, PROJ, OI, a.in[5] + (size_t)slot * GLA_HV, OG, wg, G, tid)) PH_END
#endif
        } else if (kind == 1) {
#if PON(5)
            PH_BEGIN REP(5, pool_pre_phase(HN, OG, gtid, ngt)) PH_END
#endif
        } else {
#if PON(6)
            PH_BEGIN qknorm_phase(PROJ, a.in[10], a.in[11], gw, ngw, lane); PH_END
#endif
#if PON(7)
            PH_BEGIN REP(7, attn_phase(lds, PROJ, OG, a.in[12], a.in[13], a.in[15], a.in[10], wg, tid)) PH_END
#endif
        }
        for (int pass = 0; pass < 2; ++pass) {
            if (pass == 1) {
                PH_BEGIN REP(10, norm_phase_b(XB, norm_g + (size_t)(layer * 2 + 1) * DM, HN, gw, ngw, lane)) PH_END
                PH_BEGIN
                    pg8::Gemm g{HN, W_GU + (size_t)layer * 2 * FF * DM, M, 2 * FF, DM, DM, 0};
                    pg8::StaticOrder S; S.init(M, 2 * FF, G, wg);
                    pg8::EpiSwiglu E{HID, FF};
#if PON(8)
                    REP(8, (pg8::gemm_phase<pg8::EpiSwiglu, pg8::StaticOrder, true, true>(lds, g, S, E)))
#endif
                PH_END
            }
            PH_BEGIN
                pg8::Gemm g;
                if (pass == 1) g = pg8::Gemm{HID, W_DOWN + (size_t)layer * DM * FF, M, DM, FF, FF, 0};
                else if (kind == 0) g = pg8::Gemm{OG, W_GLA_OUT + (size_t)slot * DM * DM, M, DM, DM, DM, 0};
                else if (kind == 1) g = pg8::Gemm{OG, W_POOL, M, DM, 512, DM, 1};
                else g = pg8::Gemm{OG, W_DIFF_OUT, M, DM, DM, DM, 0};
                pg8::StaticOrder S; S.init(M, DM, G, wg, 4);
                const bool last_add = (layer == 3 && pass == 1); final_phase = last_add;
                pg8::EpiResid E{(const void*)XB, last_add ? (void*)X : (void*)XB, DM, last_add ? 1 : 0};
#if PON(9)
                pg8::gemm_phase<pg8::EpiResid, pg8::StaticOrder, true, true>(lds, g, S, E);
#endif
            PH_END
        }
        if (layer < 3) {
            PH_BEGIN REP(10, norm_phase_b(XB, norm_g + (size_t)((layer + 1) * 2) * DM, HN, gw, ngw, lane)) PH_END
        }
    }
#undef PH_BEGIN
#undef PH_END
}

extern "C" void kernel_launch(void* const* d_in, const int* in_sizes, int n_in, void* d_out, int out_size, void* d_ws, size_t ws_size, hipStream_t stream) {
    static int grid = 0;
    if (grid == 0) {
        if (n_in != 18 || out_size != M * DM || ws_size < WS_END) { fprintf(stderr, "kernel_launch: unexpected shapes (n_in %d out %d ws %zu)\n", n_in, out_size, ws_size); grid = -1; return; }
        int dev = 0, cus = 0, per_cu = 0;
        (void)hipGetDevice(&dev);
        (void)hipDeviceGetAttribute(&cus, hipDeviceAttributeMultiprocessorCount, dev);
        if (hipFuncSetAttribute((const void*)mega_fwd, hipFuncAttributeMaxDynamicSharedMemorySize, LDS_BYTES) != hipSuccess) { fprintf(stderr, "kernel_launch: hipFuncSetAttribute failed\n"); grid = -1; return; }
        if (hipOccupancyMaxActiveBlocksPerMultiprocessor(&per_cu, (const void*)mega_fwd, NTHR, LDS_BYTES) != hipSuccess || per_cu < 1) { fprintf(stderr, "kernel_launch: occupancy query says %d\n", per_cu); per_cu = 1; }
        (void)hipGetLastError();
        grid = cus * per_cu;
        if (grid != 256) { fprintf(stderr, "kernel_launch: built for a 256-workgroup grid (256 CUs x 1), got %d x %d\n", cus, per_cu); if (grid > 256) grid = 256; }
    }
    if (grid < 0) return;
    if (hipMemsetAsync((char*)d_ws + WS_BAR, 0, 16384, stream) != hipSuccess) { fprintf(stderr, "kernel_launch: memset of the barrier words failed\n"); return; }
    Args a{};
    for (int i = 0; i < 18; ++i) a.in[i] = (const float*)d_in[i];
    a.out = (float*)d_out; a.ws = (unsigned char*)d_ws; a.lo = 0; a.hi = 1 << 30;
    void* args[] = {&a};
    hipError_t e = hipLaunchCooperativeKernel((const void*)mega_fwd, dim3(grid), dim3(NTHR), args, LDS_BYTES, stream);
    if (e != hipSuccess) fprintf(stderr, "kernel_launch: cooperative launch failed: %s (grid %d)\n", hipGetErrorString(e), grid);
}
```

```cpp
#include <hip/hip_runtime.h>
#include <hip/hip_cooperative_groups.h>
#include <cstdio>
#include <cstdint>
namespace cg = cooperative_groups;

namespace pg8 {
#define PG8_LAS __attribute__((address_space(3)))
typedef unsigned short bf16_t;
typedef short bf16x8 __attribute__((ext_vector_type(8)));
typedef float f32x4 __attribute__((ext_vector_type(4)));
typedef unsigned u32x4 __attribute__((ext_vector_type(4)));
constexpr int BM = 256, BK = 64, HALF = 128, HTB = HALF * BK * 2, STAGE_BYTES = 8 * HTB, NXCD = 8, WGM = 8;

__host__ __device__ __forceinline__ int lds_byte(int r, int c) { const int st = (r >> 4) * 2 + (c >> 5), rr = r & 15, cc = c & 31, ob = rr * 64 + cc * 2; return st * 1024 + (ob ^ (((ob >> 9) & 1) << 5)); }
__host__ __device__ __forceinline__ void stage_rc(int b, int& R, int& C) { const int st = b / 1024, sb = b % 1024, swz = sb ^ (((sb >> 9) & 1) << 5); R = (st >> 1) * 16 + swz / 64; C = (st & 1) * 32 + (swz % 64) / 2; }
__host__ __device__ __forceinline__ int perm32(int rho) { const int n = rho >> 4, i = rho & 15; return 8 * (i >> 2) + 4 * n + (i & 3); }

struct Unit { int pm, pn; };
struct Gemm { const bf16_t* A; const bf16_t* Bt; int M, N, K, lda, agrp;
    __device__ __forceinline__ size_t aofs(int pn) const { return agrp ? (size_t)(pn >> 1) * 1024u : (size_t)0; } };

struct StaticOrder {
    int nM, nN, nwg, G, c, wgm;
    __host__ __device__ void init(int M, int N, int G_, int c_, int wgm_ = WGM) { nM = M / BM; nN = N / BM; nwg = nM * nN; G = G_; c = c_; wgm = wgm_; }
    __host__ __device__ bool next(int i, Unit& u) const {
        const long L = (long)i * G + c; if (L >= nwg) return false;
        int wgid = (int)L; { const int q = nwg / NXCD, r = nwg % NXCD, xcd = wgid % NXCD, off = wgid / NXCD; wgid = (xcd < r ? xcd * (q + 1) : r * (q + 1) + (xcd - r) * q) + off; }
        const int nig = wgm * nN, gid = wgid / nig, fm = gid * wgm, gsz = (nM - fm) < wgm ? (nM - fm) : wgm;
        u.pm = fm + ((wgid % nig) % gsz); u.pn = (wgid % nig) / gsz; return true;
    }
    __device__ __forceinline__ void a_ready(const Unit&) const {}
    __device__ __forceinline__ void done(const Unit&) const {}
};

typedef float f32x2_t __attribute__((ext_vector_type(2))); typedef __bf16 bf16x2_t __attribute__((ext_vector_type(2)));
__device__ __forceinline__ unsigned cvt_pk_bf16(float lo, float hi) { const f32x2_t v = {lo, hi}; const bf16x2_t b = __builtin_convertvector(v, bf16x2_t); return __builtin_bit_cast(unsigned, b); }

struct EpiStore {
    static constexpr bool PERM = true, AFTER_DRAIN = false;
    bf16_t* O; int ldc;
    __device__ __forceinline__ void init(f32x4 (&acc)[2][2][4][2], const Unit&, int, int, int, int) const {
#pragma unroll
        for (int a = 0; a < 2; ++a)
#pragma unroll
            for (int b = 0; b < 2; ++b)
#pragma unroll
                for (int m = 0; m < 4; ++m)
#pragma unroll
                    for (int n = 0; n < 2; ++n) acc[a][b][m][n] = (f32x4){0.f, 0.f, 0.f, 0.f};
    }
    __device__ __forceinline__ void operator()(const f32x4 (&acc)[2][2][4][2], const Unit& u, int wr, int wc, int fr, int fq) const {
        const int row0 = u.pm * BM + wr * 64 + fr; const int col0 = u.pn * BM + wc * 32 + 8 * fq;
#pragma unroll
        for (int ai = 0; ai < 2; ++ai)
#pragma unroll
            for (int m = 0; m < 4; ++m) { bf16_t* rowp = O + (size_t)(row0 + ai * HALF + m * 16) * ldc + col0;
#pragma unroll
                for (int bj = 0; bj < 2; ++bj) { const f32x4 v0 = acc[ai][bj][m][0], v1 = acc[ai][bj][m][1];
                    u32x4 w; w.x = cvt_pk_bf16(v0[0], v0[1]); w.y = cvt_pk_bf16(v0[2], v0[3]); w.z = cvt_pk_bf16(v1[0], v1[1]); w.w = cvt_pk_bf16(v1[2], v1[3]);
                    *(u32x4*)(rowp + bj * HALF) = w; } }
    }
};
__device__ __forceinline__ float silu_f(float g) { return g * __builtin_amdgcn_rcpf(1.0f + __expf(-g)); }
struct EpiSwiglu {
    static constexpr bool PERM = true, AFTER_DRAIN = false;
    bf16_t* O; int ldc;
    __device__ __forceinline__ void init(f32x4 (&acc)[2][2][4][2], const Unit&, int, int, int, int) const {
#pragma unroll
        for (int a = 0; a < 2; ++a)
#pragma unroll
            for (int b = 0; b < 2; ++b)
#pragma unroll
                for (int m = 0; m < 4; ++m)
#pragma unroll
                    for (int n = 0; n < 2; ++n) acc[a][b][m][n] = (f32x4){0.f, 0.f, 0.f, 0.f};
    }
    __device__ __forceinline__ void operator()(const f32x4 (&acc)[2][2][4][2], const Unit& u, int wr, int wc, int fr, int fq) const {
        const int row0 = u.pm * BM + wr * 64 + fr; const int col0 = u.pn * HALF + wc * 32 + 8 * fq;
#pragma unroll
        for (int ai = 0; ai < 2; ++ai)
#pragma unroll
            for (int m = 0; m < 4; ++m) { bf16_t* rowp = O + (size_t)(row0 + ai * HALF + m * 16) * ldc + col0;
                const f32x4 g0 = acc[ai][0][m][0], g1 = acc[ai][0][m][1], u0 = acc[ai][1][m][0], u1 = acc[ai][1][m][1];
                u32x4 w; w.x = cvt_pk_bf16(silu_f(g0[0]) * u0[0], silu_f(g0[1]) * u0[1]); w.y = cvt_pk_bf16(silu_f(g0[2]) * u0[2], silu_f(g0[3]) * u0[3]);
                w.z = cvt_pk_bf16(silu_f(g1[0]) * u1[0], silu_f(g1[1]) * u1[1]); w.w = cvt_pk_bf16(silu_f(g1[2]) * u1[2], silu_f(g1[3]) * u1[3]);
                *(u32x4*)rowp = w; asm volatile("" ::: "memory"); }
    }
};
struct EpiResid {
    static constexpr bool PERM = true, AFTER_DRAIN = false;
    const void* Xin; void* Xout; int ldc; int out_f32;
    __device__ __forceinline__ void init(f32x4 (&acc)[2][2][4][2], const Unit& u, int wr, int wc, int fr, int fq) const {
        const int row0 = u.pm * BM + wr * 64 + fr; const int col0 = u.pn * BM + wc * 32 + 8 * fq;
        { const bf16_t* xi = (const bf16_t*)Xin;
#pragma unroll
            for (int ai = 0; ai < 2; ++ai)
#pragma unroll
                for (int m = 0; m < 4; ++m)
#pragma unroll
                    for (int bj = 0; bj < 2; ++bj) { const u32x4 w = *(const u32x4*)(xi + (size_t)(row0 + ai * HALF + m * 16) * ldc + col0 + bj * HALF);
                        acc[ai][bj][m][0] = (f32x4){__uint_as_float(w.x << 16), __uint_as_float(w.x & 0xffff0000u), __uint_as_float(w.y << 16), __uint_as_float(w.y & 0xffff0000u)};
                        acc[ai][bj][m][1] = (f32x4){__uint_as_float(w.z << 16), __uint_as_float(w.z & 0xffff0000u), __uint_as_float(w.w << 16), __uint_as_float(w.w & 0xffff0000u)}; }
        }
    }
    __device__ __forceinline__ void operator()(const f32x4 (&acc)[2][2][4][2], const Unit& u, int wr, int wc, int fr, int fq) const {
        const int row0 = u.pm * BM + wr * 64 + fr; const int col0 = u.pn * BM + wc * 32 + 8 * fq;
        if (out_f32) { float* xo = (float*)Xout;
#pragma unroll
            for (int ai = 0; ai < 2; ++ai)
#pragma unroll
                for (int m = 0; m < 4; ++m)
#pragma unroll
                    for (int bj = 0; bj < 2; ++bj)
#pragma unroll
                        for (int n = 0; n < 2; ++n) *(f32x4*)(xo + (size_t)(row0 + ai * HALF + m * 16) * ldc + col0 + bj * HALF + 4 * n) = acc[ai][bj][m][n];
        } else { bf16_t* xo = (bf16_t*)Xout;
#pragma unroll
            for (int ai = 0; ai < 2; ++ai)
#pragma unroll
                for (int m = 0; m < 4; ++m)
#pragma unroll
                    for (int bj = 0; bj < 2; ++bj) { const f32x4 v0 = acc[ai][bj][m][0], v1 = acc[ai][bj][m][1];
                        u32x4 w; w.x = cvt_pk_bf16(v0[0], v0[1]); w.y = cvt_pk_bf16(v0[2], v0[3]); w.z = cvt_pk_bf16(v1[0], v1[1]); w.w = cvt_pk_bf16(v1[2], v1[3]);
                        *(u32x4*)(xo + (size_t)(row0 + ai * HALF + m * 16) * ldc + col0 + bj * HALF) = w; }
        }
    }
};

template <class Epi, class Sched, bool ALIGN_EPI = false, bool SP2 = false>
__device__ __forceinline__ void gemm_phase(PG8_LAS unsigned char* lds, const Gemm g, const Sched& S, const Epi& E) {
    int tid_o = threadIdx.x; asm volatile("" : "+v"(tid_o)); const int tid = tid_o, wid = __builtin_amdgcn_readfirstlane(tid >> 6), lane = tid & 63, wr = wid >> 2, wc = wid & 3, fr = lane & 15, fq = lane >> 4;
    const int K = g.K, nt = K / BK;
    unsigned voffA[2], voffB[2];
#pragma unroll
    for (int i = 0; i < 2; ++i) { int R, C; stage_rc(tid * 16 + i * 8192, R, C); const int Rb = Epi::PERM ? ((R & ~31) + perm32(R & 31)) : R;
        voffA[i] = (unsigned)(R * g.lda + C) * 2u; voffB[i] = (unsigned)(Rb * K + C) * 2u; }
    const size_t kstep = (size_t)(BK * 2);
    const size_t hstepA = (size_t)HALF * g.lda * 2, hstepB = (size_t)HALF * K * 2;
    const size_t tstepA = 2 * hstepA, tstepB = 2 * hstepB;
    const unsigned ldsw = (unsigned)wid * 1024u;
    const int aoff = lds_byte(wr * 64 + fr, fq * 8), boff = lds_byte(wc * 32 + fr, fq * 8);
#define PG8_SA(b, h) (((b) * 2 + (h)) * HTB)
#define PG8_SB(b, h) ((4 + (b) * 2 + (h)) * HTB)
#define PG8_STAGE(bufoff, gbase, voff) do { _Pragma("unroll") for (int _i = 0; _i < 2; ++_i) \
        __builtin_amdgcn_global_load_lds((const unsigned*)((const char*)(gbase) + (voff)[_i]), (PG8_LAS unsigned*)(lds + (bufoff) + ldsw + _i * 8192), 16, 0, 0); } while (0)
#define PG8_LDA(dst, b, h) do { _Pragma("unroll") for (int m = 0; m < 4; ++m) _Pragma("unroll") for (int k = 0; k < 2; ++k) dst[m][k] = *(const PG8_LAS bf16x8*)(lds + PG8_SA(b, h) + aoff + m * 2048 + k * 1024); } while (0)
#define PG8_LDB(dst, b, h) do { _Pragma("unroll") for (int n = 0; n < 2; ++n) _Pragma("unroll") for (int k = 0; k < 2; ++k) dst[n][k] = *(const PG8_LAS bf16x8*)(lds + PG8_SB(b, h) + boff + n * 2048 + k * 1024); } while (0)
#define PG8_MMA(ai, bj, At, Bt) do { __builtin_amdgcn_s_setprio(1); _Pragma("unroll") for (int m = 0; m < 4; ++m) _Pragma("unroll") for (int n = 0; n < 2; ++n) _Pragma("unroll") for (int k = 0; k < 2; ++k) \
        acc[ai][bj][m][n] = __builtin_amdgcn_mfma_f32_16x16x32_bf16(Bt[n][k], At[m][k], acc[ai][bj][m][n], 0, 0, 0); __builtin_amdgcn_s_setprio(0); } while (0)
#define PG8_WAIT_V(n) asm volatile("s_waitcnt vmcnt(" #n ")" ::: "memory")
#define PG8_WAIT_L(n) asm volatile("s_waitcnt lgkmcnt(" #n ")" ::: "memory")
#define PG8_BAR __builtin_amdgcn_s_barrier()
#define PG8_SCHED __builtin_amdgcn_sched_barrier(0)
    Unit cur, nxt; int ui = 0;
    if (!S.next(0, cur)) return;
    f32x4 acc[2][2][4][2];
    E.init(acc, cur, wr, wc, fr, fq);
    bf16x8 At[4][2], B0[2][2], B1[2][2];
    const char* cA = (const char*)g.A + (size_t)cur.pm * tstepA + g.aofs(cur.pn); const char* cB = (const char*)g.Bt + (size_t)cur.pn * tstepB;
    S.a_ready(cur);
    if constexpr (SP2) {
        PG8_STAGE(PG8_SB(0, 0), cB, voffB); PG8_STAGE(PG8_SB(0, 1), cB + hstepB, voffB); PG8_STAGE(PG8_SA(0, 0), cA, voffA); PG8_STAGE(PG8_SA(0, 1), cA + hstepA, voffA);
        if (wr == 1) PG8_BAR;
        PG8_WAIT_V(2); PG8_BAR;
        PG8_STAGE(PG8_SB(1, 0), cB + kstep, voffB); PG8_STAGE(PG8_SA(1, 0), cA + kstep, voffA); PG8_STAGE(PG8_SB(1, 1), cB + hstepB + kstep, voffB);
        PG8_WAIT_V(6); PG8_BAR;
    } else {
        PG8_STAGE(PG8_SB(0, 0), cB, voffB); PG8_STAGE(PG8_SA(0, 0), cA, voffA); PG8_STAGE(PG8_SB(0, 1), cB + hstepB, voffB); PG8_STAGE(PG8_SA(0, 1), cA + hstepA, voffA);
        if (wr == 1) PG8_BAR;
        PG8_WAIT_V(4); PG8_BAR;
        PG8_STAGE(PG8_SB(1, 0), cB + kstep, voffB); PG8_STAGE(PG8_SA(1, 0), cA + kstep, voffA); PG8_STAGE(PG8_SB(1, 1), cB + hstepB + kstep, voffB);
        PG8_WAIT_V(6); PG8_BAR;
    }
    for (;;) {
        const bool has_next = S.next(ui + 1, nxt);
        const char* nA = has_next ? (const char*)g.A + (size_t)nxt.pm * tstepA + g.aofs(nxt.pn) : cA; const char* nB = has_next ? (const char*)g.Bt + (size_t)nxt.pn * tstepB : cB;
        for (int t = 0; t < nt; t += 2) {
            const bool last = (t == nt - 2);
            const char* a1 = cA + (size_t)(t + 1) * kstep;
            const char* a2 = last ? nA : cA + (size_t)(t + 2) * kstep; const char* b2 = last ? nB : cB + (size_t)(t + 2) * kstep;
            const char* a3 = a2 + kstep; const char* b3 = b2 + kstep;
            if (last && has_next) S.a_ready(nxt);
            if constexpr (SP2) {
            PG8_LDB(B0, 0, 0); PG8_LDB(B1, 0, 1); PG8_SCHED; PG8_LDA(At, 0, 0); PG8_STAGE(PG8_SA(1, 1), a1 + hstepA, voffA);
            PG8_WAIT_V(8); PG8_WAIT_L(0); PG8_BAR; PG8_MMA(0, 0, At, B0); PG8_MMA(0, 1, At, B1); PG8_BAR; PG8_SCHED;
            PG8_LDA(At, 0, 1); PG8_STAGE(PG8_SB(0, 0), b2, voffB); PG8_STAGE(PG8_SB(0, 1), b2 + hstepB, voffB); PG8_STAGE(PG8_SA(0, 0), a2, voffA);
            PG8_WAIT_V(8); PG8_WAIT_L(0); PG8_BAR; PG8_MMA(1, 0, At, B0); PG8_MMA(1, 1, At, B1); PG8_BAR; PG8_SCHED;
            PG8_LDB(B0, 1, 0); PG8_LDB(B1, 1, 1); PG8_SCHED; PG8_LDA(At, 1, 0); PG8_STAGE(PG8_SA(0, 1), a2 + hstepA, voffA);
            PG8_WAIT_V(8); PG8_WAIT_L(0); PG8_BAR; PG8_MMA(0, 0, At, B0); PG8_MMA(0, 1, At, B1); PG8_BAR; PG8_SCHED;
            PG8_LDA(At, 1, 1); PG8_STAGE(PG8_SB(1, 0), b3, voffB); PG8_STAGE(PG8_SB(1, 1), b3 + hstepB, voffB); PG8_STAGE(PG8_SA(1, 0), a3, voffA);
            PG8_WAIT_V(8); PG8_WAIT_L(0); PG8_BAR; PG8_MMA(1, 0, At, B0); PG8_MMA(1, 1, At, B1); PG8_BAR; PG8_SCHED;
            } else {
            PG8_LDB(B0, 0, 0); PG8_SCHED; PG8_LDA(At, 0, 0); PG8_STAGE(PG8_SA(1, 1), a1 + hstepA, voffA);
            PG8_WAIT_L(8); PG8_BAR; PG8_WAIT_L(0); PG8_MMA(0, 0, At, B0); PG8_BAR; PG8_SCHED;
            PG8_LDB(B1, 0, 1); PG8_STAGE(PG8_SB(0, 0), b2, voffB);
            PG8_BAR; PG8_WAIT_L(0); PG8_MMA(0, 1, At, B1); PG8_BAR;
            PG8_LDA(At, 0, 1); PG8_STAGE(PG8_SA(0, 0), a2, voffA);
            PG8_BAR; PG8_WAIT_L(0); PG8_MMA(1, 0, At, B0); PG8_BAR; PG8_SCHED;
            PG8_STAGE(PG8_SB(0, 1), b2 + hstepB, voffB);
            PG8_WAIT_V(6); PG8_BAR; PG8_MMA(1, 1, At, B1); PG8_BAR;
            PG8_LDB(B0, 1, 0); PG8_SCHED; PG8_LDA(At, 1, 0); PG8_STAGE(PG8_SA(0, 1), a2 + hstepA, voffA);
            PG8_WAIT_L(8); PG8_BAR; PG8_WAIT_L(0); PG8_MMA(0, 0, At, B0); PG8_BAR; PG8_SCHED;
            PG8_LDB(B1, 1, 1); PG8_STAGE(PG8_SB(1, 0), b3, voffB);
            PG8_BAR; PG8_WAIT_L(0); PG8_MMA(0, 1, At, B1); PG8_BAR;
            PG8_LDA(At, 1, 1); PG8_STAGE(PG8_SA(1, 0), a3, voffA);
            PG8_BAR; PG8_WAIT_L(0); PG8_MMA(1, 0, At, B0); PG8_BAR; PG8_SCHED;
            PG8_STAGE(PG8_SB(1, 1), b3 + hstepB, voffB);
            PG8_WAIT_V(6); PG8_BAR; PG8_MMA(1, 1, At, B1); PG8_BAR;
            }
        }
        if constexpr (ALIGN_EPI) { if (wr == 0) PG8_BAR; }
        if constexpr (!Epi::AFTER_DRAIN) { E(acc, cur, wr, wc, fr, fq); S.done(cur); }
        if (!has_next) break;
        E.init(acc, nxt, wr, wc, fr, fq);
        cur = nxt; cA = nA; cB = nB; ++ui;
        if constexpr (ALIGN_EPI) { if (wr == 1) PG8_BAR; }
    }
    PG8_WAIT_V(0);
    if constexpr (!ALIGN_EPI) { if (wr == 0) PG8_BAR; }
    PG8_BAR;
    if constexpr (Epi::AFTER_DRAIN) { E.fused(acc, cur, wr, wc, fr, fq, lds, wid, lane); S.done(cur); }
#undef PG8_SA
#undef PG8_SB
#undef PG8_STAGE
#undef PG8_LDA
#undef PG8_LDB
#undef PG8_MMA
#undef PG8_WAIT_V
#undef PG8_WAIT_L
#undef PG8_BAR
#undef PG8_SCHED
}}

constexpr int NB = 4, SEQ = 4096, DM = 2048, M = NB * SEQ;
constexpr int GLA_H = 4, GLA_DK = 1024, GLA_DV = 2048, GLA_HK = 256, GLA_HV = 512, GLA_RANK = 16, GLA_C = 64, GLA_NC = SEQ / GLA_C, GLA_IN = 6160, GLA_INP = 6400  , GLA_PP = 6144  ;
constexpr int FF = 5632, DIFF_IN = 6144;
constexpr float EPS = 1e-6f, LOG2E = 1.4426950408889634f;
constexpr float LAM_INIT = 0.47071302f;
constexpr float QSCALE = 0.08838834764831845f * LOG2E;

constexpr size_t MiB = 1u << 20;
constexpr size_t WS_GLA_IN = 0;
constexpr size_t WS_GLA_OUT = 50 * MiB;
constexpr size_t WS_POOL = 66 * MiB;
constexpr size_t WS_DIFF_IN = 68 * MiB;
constexpr size_t WS_DIFF_OUT = 92 * MiB;
constexpr size_t WS_GU = 100 * MiB;
constexpr size_t WS_DOWN = 276 * MiB;
constexpr size_t WS_HN = 364 * MiB;
constexpr size_t WS_PROJ = 428 * MiB;
constexpr size_t WS_HID = 628 * MiB;
constexpr size_t WS_QT = 804 * MiB, WS_KT = 836 * MiB, WS_KH = 868 * MiB;
constexpr size_t WS_DEC = 900 * MiB;
constexpr size_t WS_OI = 901 * MiB;
constexpr size_t WS_OG = 1029 * MiB;
constexpr size_t WS_BAR = 1093 * MiB;
constexpr size_t WS_XB = 1094 * MiB;
constexpr size_t WS_END = 1158 * MiB;

constexpr int MISC_OFF = 152576;
constexpr int LDS_BYTES = 155648;
constexpr int NWAVES = 8, NTHR = 512;

#define LAS __attribute__((address_space(3)))
typedef unsigned short bf16_t;
typedef short bf16x8 __attribute__((ext_vector_type(8)));
typedef short s16x4 __attribute__((ext_vector_type(4)));
typedef float f32x4 __attribute__((ext_vector_type(4)));
typedef float f32x2 __attribute__((ext_vector_type(2)));
typedef unsigned u32x4 __attribute__((ext_vector_type(4)));
typedef unsigned u32x2 __attribute__((ext_vector_type(2)));

__device__ __forceinline__ unsigned cvtpk(float lo, float hi) { return pg8::cvt_pk_bf16(lo, hi); }
__device__ __forceinline__ float bflo(unsigned u) { return __uint_as_float(u << 16); }
__device__ __forceinline__ float bfhi(unsigned u) { return __uint_as_float(u & 0xffff0000u); }
__device__ __forceinline__ float bf2f(bf16_t u) { return __uint_as_float((unsigned)u << 16); }
__device__ __forceinline__ float wave_sum(float v) {
#pragma unroll
    for (int o = 1; o < 64; o <<= 1) v += __shfl_xor(v, o);
    return v;
}
__device__ __forceinline__ f32x4 mma16(bf16x8 a, bf16x8 b, f32x4 c) { return __builtin_amdgcn_mfma_f32_16x16x32_bf16(a, b, c, 0, 0, 0); }
__device__ __forceinline__ bf16x8 frag_rowk(const LAS bf16_t* T, int pitch, int r0, int k0, int fr, int fq) {
    return *(const LAS bf16x8*)(T + (r0 + fr) * pitch + k0 + 8 * fq);
}
__device__ __forceinline__ bf16x8 frag_tr2(const LAS bf16_t* T, int pitch, int rowA, int rowB, int c0, int fr) {
    const LAS bf16_t* pa = T + (rowA + (fr >> 2)) * pitch + c0 + 4 * (fr & 3);
    const LAS bf16_t* pb = T + (rowB + (fr >> 2)) * pitch + c0 + 4 * (fr & 3);
    const s16x4 a = __builtin_amdgcn_ds_read_tr16_b64_v4i16((LAS s16x4*)pa);
    const s16x4 b = __builtin_amdgcn_ds_read_tr16_b64_v4i16((LAS s16x4*)pb);
    return (bf16x8){a[0], a[1], a[2], a[3], b[0], b[1], b[2], b[3]};
}
__device__ __forceinline__ bf16x8 frag_tr(const LAS bf16_t* T, int pitch, int k0, int c0, int fr, int fq) { return frag_tr2(T, pitch, k0 + 8 * fq, k0 + 8 * fq + 4, c0, fr); }

struct Args { const float* in[18]; float* out; unsigned char* ws; int lo, hi; };

__device__ __forceinline__ void conv_matrix(const float* W, int K, int N, int Nv, bf16_t* WT, int mode, LAS float* scr, int gw, int ngw, int lane, const float* nscale = nullptr) {
    const int nblk = Nv / 64, nitems = (K / 64) * nblk;
    const int r4 = lane >> 4, c4 = (lane & 15) * 4;
    for (int it = gw; it < nitems; it += ngw) {
        const int kb = it / nblk, nb = it % nblk, k0 = 64 * kb, n0 = 64 * nb;
        const bool ok = (n0 + c4) < N;
        const float* src = W + (size_t)(k0 + r4) * N + n0 + c4;
        f32x4 v[16];
#pragma unroll
        for (int i = 0; i < 16; ++i) v[i] = ok ? *(const f32x4*)(src + (size_t)(4 * i) * N) : (f32x4){0.f, 0.f, 0.f, 0.f};
        if (nscale) { const f32x4 s4 = *(const f32x4*)(nscale + n0 + c4);
#pragma unroll
            for (int i = 0; i < 16; ++i) v[i] = v[i] * s4; }
#pragma unroll
        for (int i = 0; i < 16; ++i) { LAS float* q = scr + (4 * i + r4) * 65 + c4; q[0] = v[i][0]; q[1] = v[i][1]; q[2] = v[i][2]; q[3] = v[i][3]; }
        asm volatile("s_waitcnt lgkmcnt(0)" ::: "memory");
        int d0 = n0;
        if (mode == 1) { d0 = (n0 < FF) ? (256 * (n0 / 128) + (n0 % 128)) : (256 * ((n0 - FF) / 128) + 128 + ((n0 - FF) % 128)); }
        const int ns = lane >> 3, c = lane & 7;
        bf16_t* dst = WT + (size_t)(d0 + ns) * K + k0 + 8 * c;
        const LAS float* sp = scr + (8 * c) * 65 + ns;
#pragma unroll
        for (int i = 0; i < 8; ++i) { u32x4 o;
            o.x = cvtpk(sp[8 * i + 0 * 65], sp[8 * i + 1 * 65]); o.y = cvtpk(sp[8 * i + 2 * 65], sp[8 * i + 3 * 65]);
            o.z = cvtpk(sp[8 * i + 4 * 65], sp[8 * i + 5 * 65]); o.w = cvtpk(sp[8 * i + 6 * 65], sp[8 * i + 7 * 65]);
            *(u32x4*)(dst + (size_t)(8 * i) * K) = o; }
        asm volatile("s_waitcnt lgkmcnt(0)" ::: "memory");
    }
}

template <int NR>
__device__ __forceinline__ void norm_rows(const float* xrow, const float* g, bf16_t* orow, bf16_t* crow, int lane) {
    f32x4 v[NR][8]; float s[NR];
#pragma unroll
    for (int r = 0; r < NR; ++r) { const f32x4* xr = (const f32x4*)(xrow + (size_t)r * DM) + lane;
#pragma unroll
        for (int j = 0; j < 8; ++j) v[r][j] = xr[64 * j]; }
#pragma unroll
    for (int r = 0; r < NR; ++r) { s[r] = 0.f;
#pragma unroll
        for (int j = 0; j < 8; ++j) s[r] += (v[r][j].x * v[r][j].x + v[r][j].y * v[r][j].y) + (v[r][j].z * v[r][j].z + v[r][j].w * v[r][j].w);
        s[r] = 1.0f / sqrtf(wave_sum(s[r]) * (1.f / DM) + EPS); }
#pragma unroll
    for (int j = 0; j < 8; ++j) { const f32x4 gg = *((const f32x4*)g + lane + 64 * j);
#pragma unroll
        for (int r = 0; r < NR; ++r) { u32x2 w; w.x = cvtpk(v[r][j].x * s[r] * gg.x, v[r][j].y * s[r] * gg.y); w.y = cvtpk(v[r][j].z * s[r] * gg.z, v[r][j].w * s[r] * gg.w);
            *((u32x2*)(orow + (size_t)r * DM) + lane + 64 * j) = w;
            u32x2 c; c.x = cvtpk(v[r][j].x, v[r][j].y); c.y = cvtpk(v[r][j].z, v[r][j].w); *((u32x2*)(crow + (size_t)r * DM) + lane + 64 * j) = c; } }
}
template <int NR>
__device__ __forceinline__ void norm_rows_b(const bf16_t* xrow, const float* g, bf16_t* orow, int lane) {
    u32x4 v[NR][4]; float s[NR];
#pragma unroll
    for (int r = 0; r < NR; ++r) { const u32x4* xr = (const u32x4*)(xrow + (size_t)r * DM) + lane;
#pragma unroll
        for (int j = 0; j < 4; ++j) v[r][j] = xr[64 * j]; }
#pragma unroll
    for (int r = 0; r < NR; ++r) { s[r] = 0.f;
#pragma unroll
        for (int j = 0; j < 4; ++j)
#pragma unroll
            for (int e = 0; e < 4; ++e) { const float a = bflo(v[r][j][e]), c = bfhi(v[r][j][e]); s[r] += a * a + c * c; }
        s[r] = 1.0f / sqrtf(wave_sum(s[r]) * (1.f / DM) + EPS); }
#pragma unroll
    for (int j = 0; j < 4; ++j) { const f32x4 g0 = *((const f32x4*)g + 2 * (lane + 64 * j)), g1 = *((const f32x4*)g + 2 * (lane + 64 * j) + 1);
#pragma unroll
        for (int r = 0; r < NR; ++r) { u32x4 w;
            w.x = cvtpk(bflo(v[r][j].x) * s[r] * g0[0], bfhi(v[r][j].x) * s[r] * g0[1]); w.y = cvtpk(bflo(v[r][j].y) * s[r] * g0[2], bfhi(v[r][j].y) * s[r] * g0[3]);
            w.z = cvtpk(bflo(v[r][j].z) * s[r] * g1[0], bfhi(v[r][j].z) * s[r] * g1[1]); w.w = cvtpk(bflo(v[r][j].w) * s[r] * g1[2], bfhi(v[r][j].w) * s[r] * g1[3]);
            *((u32x4*)(orow + (size_t)r * DM) + lane + 64 * j) = w; } }
}
__device__ __forceinline__ void norm_phase(const float* x, const float* g, bf16_t* hn, bf16_t* cp, int gw, int ngw, int lane) {
#pragma unroll 1
    for (int m = gw * 2; m < M; m += ngw * 2) norm_rows<2>(x + (size_t)m * DM, g, hn + (size_t)m * DM, cp + (size_t)m * DM, lane);
}
__device__ __forceinline__ void norm_phase_b(const bf16_t* x, const float* g, bf16_t* hn, int gw, int ngw, int lane) {
#pragma unroll 1
    for (int m = gw * 2; m < M; m += ngw * 2) norm_rows_b<2>(x + (size_t)m * DM, g, hn + (size_t)m * DM, lane);
}

__device__ __forceinline__ void pool_pre_phase(const bf16_t* hn, bf16_t* yp, int gtid, int ngt) {
    for (int idx = gtid; idx < NB * (SEQ / 64) * (DM / 2); idx += ngt) {
        const int cp = idx & 1023, run = idx >> 10, col = cp * 2, g = col >> 9, w = 2 << g;
        const int tr0 = (run & 63) * 64;
        const size_t row0 = (size_t)run * 64;
        const bf16_t* p = hn + row0 * DM + col;
        float r0[16], r1[16]; float s0 = 0.f, s1 = 0.f;
#pragma unroll
        for (int i = 0; i < 16; ++i) { r0[i] = 0.f; r1[i] = 0.f; }
        if (tr0 > 0) {
#pragma unroll
            for (int i = 1; i < 16; ++i) { const unsigned v = *(const unsigned*)(p - (size_t)(16 - i) * DM); r0[i] = bflo(v); r1[i] = bfhi(v);
                if (16 - i <= w) { s0 += r0[i]; s1 += r1[i]; } }
        }
        for (int tb = 0; tb < 64; tb += 16) {
#pragma unroll
            for (int i = 0; i < 16; ++i) { const int t = tb + i; const unsigned v = *(const unsigned*)(p + (size_t)t * DM);
                const float n0 = bflo(v), n1 = bfhi(v);
                const float o0 = r0[(i + 16 - w) & 15], o1 = r1[(i + 16 - w) & 15];
                s0 += n0 - o0; s1 += n1 - o1; r0[i] = n0; r1[i] = n1;
                const int cnt = (tr0 + t + 1 < w) ? (tr0 + t + 1) : w; const float inv = 1.0f / (float)cnt;
                *(unsigned*)(yp + (row0 + t) * DM + col) = cvtpk(s0 * inv - n0, s1 * inv - n1); }
        }
    }
}

__device__ __forceinline__ void qknorm_phase(bf16_t* proj, const float* qg, const float* kg, int gw, int ngw, int lane) {
    const int sub = lane >> 4, l16 = lane & 15;
    constexpr int NIT = M * 16 / 4, U = 8;
    for (int it0 = gw * U; it0 < NIT; it0 += ngw * U) {
        u32x4 v[U]; bf16_t* p[U];
#pragma unroll
        for (int u = 0; u < U; ++u) { const int G = (it0 + u) * 4 + sub, row = G >> 4, hd = 16 + (G & 15); p[u] = proj + (size_t)row * DIFF_IN + hd * 128 + l16 * 8; v[u] = *(const u32x4*)p[u]; }
#pragma unroll
        for (int u = 0; u < U; ++u) { const int hd = 16 + (((it0 + u) * 4 + sub) & 15);
            float f[8]; float ss = 0.f;
#pragma unroll
            for (int e = 0; e < 4; ++e) { f[2 * e] = bflo(v[u][e]); f[2 * e + 1] = bfhi(v[u][e]); ss += f[2 * e] * f[2 * e] + f[2 * e + 1] * f[2 * e + 1]; }
            ss += __shfl_xor(ss, 1); ss += __shfl_xor(ss, 2); ss += __shfl_xor(ss, 4); ss += __shfl_xor(ss, 8);
            const float rs = (1.0f / sqrtf(ss * (1.f / 128.f) + EPS)) * (hd < 16 ? QSCALE : 1.0f);
            const float* gp = (hd < 16 ? qg : kg) + l16 * 8;
            const f32x4 g0 = *(const f32x4*)gp, g1 = *(const f32x4*)(gp + 4);
            u32x4 o; o.x = cvtpk(f[0] * rs * g0.x, f[1] * rs * g0.y); o.y = cvtpk(f[2] * rs * g0.z, f[3] * rs * g0.w);
            o.z = cvtpk(f[4] * rs * g1.x, f[5] * rs * g1.y); o.w = cvtpk(f[6] * rs * g1.z, f[7] * rs * g1.w);
            *(u32x4*)p[u] = o; }
    }
}

__device__ __forceinline__ void attn_phase(LAS unsigned char* lds, const bf16_t* proj, bf16_t* oa, const float* lamp, const float* subg, const float* relb, const float* qg, int wg, int tid) {
    const int lane = tid & 63, wave = __builtin_amdgcn_readfirstlane(tid >> 6), fr = lane & 15, fq = lane >> 4;
    constexpr int KP = 144, VP = 272, KB_BUF = 2 * 32 * KP, VB_BUF = 32 * VP;
    LAS bf16_t* Kb = (LAS bf16_t*)lds;
    LAS bf16_t* Vb = (LAS bf16_t*)(lds + 2 * KB_BUF * 2);
    LAS float* tb = (LAS float*)(lds + 2 * KB_BUF * 2 + 2 * VB_BUF * 2);
    LAS bf16_t* Qs = (LAS bf16_t*)(lds + 2 * KB_BUF * 2 + 2 * VB_BUF * 2 + 2048);
    float lam;
    { const float s1 = lamp[lane] * lamp[128 + lane] + lamp[64 + lane] * lamp[192 + lane];
      const float s2 = lamp[256 + lane] * lamp[384 + lane] + lamp[320 + lane] * lamp[448 + lane];
      lam = expf(wave_sum(s1)) - expf(wave_sum(s2)) + LAM_INIT; }
    const int xj = wg >> 3, bh = (wg & 7) * 4 + (xj >> 3), b = bh >> 3, h = bh & 7, sx = xj & 7;
    const size_t rb = (size_t)b * SEQ;
    const bf16_t* ksrc = proj + rb * DIFF_IN + 2048 + (2 * h) * 128;
    const bf16_t* vsrc = proj + rb * DIFF_IN + 4096 + h * 256;
    if (tid < 258) { const int sub = tid >= 129 ? 1 : 0, rel = tid - 129 * sub; int bucket;
        if (rel < 16) bucket = rel; else if (rel >= 128) bucket = 31;
        else { bucket = 16 + (int)(logf((float)rel / 16.0f) / 2.0794415416798357f * 16.0f); if (bucket > 31) bucket = 31; }
        tb[sub * 132 + rel] = relb[bucket * 16 + 2 * h + sub] * LOG2E; }
    const float c31a = relb[31 * 16 + 2 * h] * LOG2E, c31b = relb[31 * 16 + 2 * h + 1] * LOG2E;
    for (int ui = 0; ui < 4; ++ui) {
        const int qb = (ui == 0) ? sx : (ui == 1) ? 15 - sx : (ui == 2) ? 16 + sx : 31 - sx;
        const int q0 = qb * 128, qw0 = q0 + wave * 16, nkt = (q0 + 128) / 32;
        LAS bf16_t* Qw = Qs + wave * (2 * 16 * KP);
#pragma unroll
        for (int s = 0; s < 2; ++s) { u32x4 qc[4]; float ss = 0.f;
#pragma unroll
            for (int ks = 0; ks < 4; ++ks) { qc[ks] = *(const u32x4*)(proj + (rb + qw0 + fr) * DIFF_IN + (2 * h + s) * 128 + 32 * ks + 8 * fq);
#pragma unroll
                for (int e = 0; e < 4; ++e) { const float a = bflo(qc[ks][e]), c = bfhi(qc[ks][e]); ss += a * a + c * c; } }
            ss += __shfl_xor(ss, 16); ss += __shfl_xor(ss, 32);
            const float rs = (1.0f / sqrtf(ss * (1.f / 128.f) + EPS)) * QSCALE;
#pragma unroll
            for (int ks = 0; ks < 4; ++ks) { const f32x4 g0 = *(const f32x4*)(qg + 32 * ks + 8 * fq), g1 = *(const f32x4*)(qg + 32 * ks + 8 * fq + 4);
                u32x4 o; o.x = cvtpk(bflo(qc[ks].x) * rs * g0[0], bfhi(qc[ks].x) * rs * g0[1]); o.y = cvtpk(bflo(qc[ks].y) * rs * g0[2], bfhi(qc[ks].y) * rs * g0[3]);
                o.z = cvtpk(bflo(qc[ks].z) * rs * g1[0], bfhi(qc[ks].z) * rs * g1[1]); o.w = cvtpk(bflo(qc[ks].w) * rs * g1[2], bfhi(qc[ks].w) * rs * g1[3]);
                *(LAS u32x4*)(Qw + (s * 16 + fr) * KP + 32 * ks + 8 * fq) = o; } }
#pragma unroll
        for (int i = 0; i < 2; ++i) { const int id = tid + 512 * i, s = id >> 9, row = (id >> 4) & 31, ch = id & 15;
            *(LAS u32x4*)(Kb + (s * 32 + row) * KP + ch * 8) = *(const u32x4*)(ksrc + (size_t)row * DIFF_IN + s * 128 + ch * 8); }
#pragma unroll
        for (int i = 0; i < 2; ++i) { const int id = tid + 512 * i, row = id >> 5, ch = id & 31;
            *(LAS u32x4*)(Vb + row * VP + ch * 8) = *(const u32x4*)(vsrc + (size_t)row * DIFF_IN + ch * 8); }
        __syncthreads();
        float l0 = 0.f, l1 = 0.f;
        f32x4 o[2][16];
#pragma unroll
        for (int s = 0; s < 2; ++s)
#pragma unroll
            for (int vt = 0; vt < 16; ++vt) o[s][vt] = (f32x4){0.f, 0.f, 0.f, 0.f};
        for (int kt = 0; kt < nkt; ++kt) {
            const int cur = kt & 1, k0 = kt * 32; const bool more = kt + 1 < nkt;
            u32x4 kr[2], vr[2];
            if (more) {
#pragma unroll
                for (int i = 0; i < 2; ++i) { const int id = tid + 512 * i, s = id >> 9, row = (id >> 4) & 31, ch = id & 15; kr[i] = *(const u32x4*)(ksrc + (size_t)(k0 + 32 + row) * DIFF_IN + s * 128 + ch * 8); }
#pragma unroll
                for (int i = 0; i < 2; ++i) { const int id = tid + 512 * i, row = id >> 5, ch = id & 31; vr[i] = *(const u32x4*)(vsrc + (size_t)(k0 + 32 + row) * DIFF_IN + ch * 8); }
            }
            if (k0 <= qw0 + 15) {
                const LAS bf16_t* Kc = Kb + cur * KB_BUF; const LAS bf16_t* Vc = Vb + cur * VB_BUF;
                const bool far = (qw0 - (k0 + 31)) >= 128;
                f32x4 st[2][2];
                int qoff = (fr * KP + 8 * fq); asm volatile("" : "+v"(qoff));
#pragma unroll
                for (int s = 0; s < 2; ++s) { const float ini = far ? (s ? c31b : c31a) : 0.f;
                    st[s][0] = (f32x4){ini, ini, ini, ini}; st[s][1] = st[s][0];
#pragma unroll
                    for (int ks = 0; ks < 4; ++ks) { const bf16x8 qfr = *(const LAS bf16x8*)(Qw + s * 16 * KP + qoff + 32 * ks);
#pragma unroll
                        for (int T = 0; T < 2; ++T) st[s][T] = mma16(frag_rowk(Kc + s * 32 * KP, KP, 16 * T, 32 * ks, fr, fq), qfr, st[s][T]); } }
                if (!far) {
#pragma unroll
                    for (int T = 0; T < 2; ++T)
#pragma unroll
                        for (int r = 0; r < 4; ++r) { const int rel = qw0 + fr - (k0 + 16 * T + 4 * fq + r); const int ri = rel < 0 ? 0 : (rel > 128 ? 128 : rel);
                            const float b0 = tb[ri], b1 = tb[132 + ri];
                            st[0][T][r] = rel < 0 ? -INFINITY : st[0][T][r] + b0; st[1][T][r] = rel < 0 ? -INFINITY : st[1][T][r] + b1; }
                }
                bf16x8 pf[2];
#pragma unroll
                for (int s = 0; s < 2; ++s) { float ps = 0.f;
#pragma unroll
                    for (int T = 0; T < 2; ++T)
#pragma unroll
                        for (int r = 0; r < 4; ++r) { const float p = __builtin_amdgcn_exp2f(st[s][T][r]); st[s][T][r] = p; ps += p; }
                    if (s == 0) l0 += ps; else l1 += ps;
                    u32x4 w; w.x = cvtpk(st[s][0][0], st[s][0][1]); w.y = cvtpk(st[s][0][2], st[s][0][3]); w.z = cvtpk(st[s][1][0], st[s][1][1]); w.w = cvtpk(st[s][1][2], st[s][1][3]);
                    pf[s] = __builtin_bit_cast(bf16x8, w); }
#pragma unroll
                for (int vt = 0; vt < 16; ++vt) { const bf16x8 vf = frag_tr2(Vc, VP, 4 * fq, 16 + 4 * fq, 16 * vt, fr);
                    o[0][vt] = mma16(vf, pf[0], o[0][vt]); o[1][vt] = mma16(vf, pf[1], o[1][vt]); }
            }
            if (more) {
                LAS bf16_t* Kn = Kb + (cur ^ 1) * KB_BUF; LAS bf16_t* Vn = Vb + (cur ^ 1) * VB_BUF;
#pragma unroll
                for (int i = 0; i < 2; ++i) { const int id = tid + 512 * i, s = id >> 9, row = (id >> 4) & 31, ch = id & 15; *(LAS u32x4*)(Kn + (s * 32 + row) * KP + ch * 8) = kr[i]; }
#pragma unroll
                for (int i = 0; i < 2; ++i) { const int id = tid + 512 * i, row = id >> 5, ch = id & 31; *(LAS u32x4*)(Vn + row * VP + ch * 8) = vr[i]; }
            }
            __syncthreads();
        }
        l0 += __shfl_xor(l0, 16); l0 += __shfl_xor(l0, 32); l1 += __shfl_xor(l1, 16); l1 += __shfl_xor(l1, 32);
        const float i0 = 1.0f / l0, i1 = lam / l1; float ss = 0.f;
#pragma unroll
        for (int vt = 0; vt < 16; ++vt) { o[0][vt] = o[0][vt] * i0 - o[1][vt] * i1; const f32x4 a = o[0][vt]; ss += (a[0] * a[0] + a[1] * a[1]) + (a[2] * a[2] + a[3] * a[3]); }
        ss += __shfl_xor(ss, 16); ss += __shfl_xor(ss, 32);
        const float rs = (1.0f / sqrtf(ss * (1.f / 256.f) + EPS)) * (1.0f - LAM_INIT);
        {   LAS bf16_t* Ow = Qw;
#pragma unroll
            for (int vt = 0; vt < 16; ++vt) { const f32x4 g = *(const f32x4*)(subg + 16 * vt + 4 * fq);
                u32x2 w; w.x = cvtpk(o[0][vt][0] * rs * g[0], o[0][vt][1] * rs * g[1]); w.y = cvtpk(o[0][vt][2] * rs * g[2], o[0][vt][3] * rs * g[3]);
                *(LAS u32x2*)(Ow + fr * 264 + 16 * vt + 4 * fq) = w; }
            asm volatile("s_waitcnt lgkmcnt(0)" ::: "memory");
#pragma unroll
            for (int i = 0; i < 8; ++i) { const int row = 2 * i + (lane >> 5), ch = lane & 31;
                const u32x4 v = *(const LAS u32x4*)(Ow + row * 264 + ch * 8);
                *(u32x4*)(oa + (rb + qw0 + row) * DM + h * 256 + ch * 8) = v; }
            asm volatile("s_waitcnt lgkmcnt(0)" ::: "memory"); }
    }
}

__device__ __forceinline__ unsigned short f2bf1(float x) { return (unsigned short)(cvtpk(x, 0.f) & 0xffffu); }
__device__ __forceinline__ void gla_pre_phase(LAS unsigned char* lds, const bf16_t* proj, const bf16_t* hn, const bf16_t* wlr, const float* wa2, const float* ba, bf16_t* QT, bf16_t* KT, bf16_t* KH, float* DEC, int wg, int nwg, int tid) {
    LAS float* alr = (LAS float*)lds;
    LAS float* tot = alr + 1024;
    LAS float* bl = tot + 256;
    LAS float* bbL = bl + 256;
    constexpr int BP = 260;
    const int d = tid & 255, half = tid >> 8;
    const int lane = tid & 63, wave = __builtin_amdgcn_readfirstlane(tid >> 6), fr = lane & 15, fq = lane >> 4;
    LAS float* part = bbL;
    for (int bc = wg; bc < NB * GLA_NC; bc += nwg) {
      const size_t t0 = (size_t)bc * 64;
      {
          const int tt = wave & 3, kh = wave >> 2;
          const bf16_t* ap = hn + (t0 + 16 * tt + fr) * DM + kh * 1024 + 8 * fq;
          const bf16_t* bp = wlr + (size_t)fr * DM + kh * 1024 + 8 * fq;
          f32x4 acc = (f32x4){0.f, 0.f, 0.f, 0.f};
#pragma unroll 8
          for (int ks = 0; ks < 32; ++ks) acc = mma16(*(const bf16x8*)(ap + 32 * ks), *(const bf16x8*)(bp + 32 * ks), acc);
          if (kh == 1) *(LAS f32x4*)(part + (tt * 64 + lane) * 4) = acc;
          __syncthreads();
          if (kh == 0) { const f32x4 o = acc + *(const LAS f32x4*)(part + (tt * 64 + lane) * 4);
#pragma unroll
              for (int rr = 0; rr < 4; ++rr) alr[(16 * tt + 4 * fq + rr) * 16 + fr] = o[rr]; }
          __syncthreads();
      }
      for (int h = 0; h < GLA_H; ++h) {
        float w[16];
#pragma unroll
        for (int r = 0; r < 16; ++r) w[r] = wa2[r * GLA_DK + h * 256 + d];
        const float bias = ba[h * 256 + d];
        __syncthreads();
        float cum = 0.f;
#pragma unroll 8
        for (int i = 0; i < 32; ++i) { const int t = half * 32 + i; float z = bias;
            const LAS f32x4* ap = (const LAS f32x4*)(alr + t * 16);
#pragma unroll
            for (int r4 = 0; r4 < 4; ++r4) { const f32x4 av = ap[r4]; z += av[0] * w[4 * r4] + av[1] * w[4 * r4 + 1] + av[2] * w[4 * r4 + 2] + av[3] * w[4 * r4 + 3]; }
            const float la = (fminf(z, 0.f) - __logf(1.0f + __expf(-fabsf(z)))) * (1.0f / 16.0f);
            cum += la; bbL[t * BP + d] = cum; }
        if (half == 0) tot[d] = cum;
        __syncthreads();
        if (half == 1) { const float blv = cum + tot[d]; bl[d] = blv; DEC[(size_t)bc * GLA_DK + h * 256 + d] = __expf(blv); }
        __syncthreads();
#pragma unroll
        for (int i = 0; i < 4; ++i) { const int id = tid + 512 * i, t = id >> 5, dg = (id & 31) * 8;
            const size_t row = t0 + t;
            const u32x4 qv = *(const u32x4*)(proj + row * GLA_PP + h * 256 + dg), kv = *(const u32x4*)(proj + row * GLA_PP + 1024 + h * 256 + dg);
            u32x4 oq, oh;
#pragma unroll
            for (int e = 0; e < 4; ++e) {
                float b0 = bbL[t * BP + dg + 2 * e], b1 = bbL[t * BP + dg + 2 * e + 1];
                if (t >= 32) { b0 += tot[dg + 2 * e]; b1 += tot[dg + 2 * e + 1]; }
                const float l0 = bl[dg + 2 * e], l1 = bl[dg + 2 * e + 1];
                const float q0 = bflo(qv[e]), q1 = bfhi(qv[e]), k0 = bflo(kv[e]), k1 = bfhi(kv[e]);
                oq[e] = cvtpk(q0 * __expf(b0) * (1.0f / 16.0f), q1 * __expf(b1) * (1.0f / 16.0f));
                oh[e] = cvtpk(k0 * __expf(l0 - b0), k1 * __expf(l1 - b1)); }
            const size_t oidx = row * GLA_DK + h * 256 + dg;
            *(u32x4*)(QT + oidx) = oq; *(u32x4*)(KH + oidx) = oh; }
        __syncthreads();
      }
    }
}

__device__ __forceinline__ void gla_seq_phase(LAS unsigned char* lds, const bf16_t* QT, const bf16_t* KH, const bf16_t* proj, const float* DEC, bf16_t* OI, int wg, int nwg, int tid) {
    const int lane = tid & 63, wave = __builtin_amdgcn_readfirstlane(tid >> 6), fr = lane & 15, fq = lane >> 4;
    constexpr int QP = 272, KHP = 272, VP = 48;
    LAS bf16_t* Qt = (LAS bf16_t*)lds;
    LAS bf16_t* Kh = (LAS bf16_t*)(lds + 34816);
    LAS bf16_t* Vt = (LAS bf16_t*)(lds + 69632);
    LAS float* dec = (LAS float*)(lds + 75776);
    LAS bf16_t* SBt = (LAS bf16_t*)(lds + 76800);
    LAS bf16_t* Ost = (LAS bf16_t*)(lds + 111616);
    for (int u = wg; u < 256; u += nwg) {
        const int uj = u >> 3, ubh = (u & 7) * 2 + (uj >> 4), vs = uj & 15, h = ubh & 3, b = ubh >> 2;
        const size_t tb0 = (size_t)b * SEQ;
        const bf16_t* qsrc = QT + tb0 * GLA_DK + h * 256;
        const bf16_t* ksrc = KH + tb0 * GLA_DK + h * 256;
        const bf16_t* vsrc = proj + tb0 * GLA_PP + 2048 + h * 512 + vs * 32;
        const float* dsrc = DEC + (size_t)b * GLA_NC * GLA_DK + h * 256;
        for (int i = tid; i < 32 * QP / 2; i += NTHR) ((LAS unsigned*)SBt)[i] = 0u;
        f32x4 S[2][2];
#pragma unroll
        for (int a = 0; a < 2; ++a)
#pragma unroll
            for (int c = 0; c < 2; ++c) S[a][c] = (f32x4){0.f, 0.f, 0.f, 0.f};
        u32x4 qr[4], kr[4], vr, dr;
        vr = (u32x4){0u, 0u, 0u, 0u}; dr = vr;
#define GLA_SEQ_LOAD(c) do { \
            _Pragma("unroll") for (int i = 0; i < 4; ++i) { const int id = tid + 512 * i, row = id >> 5, ch = id & 31; \
                qr[i] = *(const u32x4*)(qsrc + (size_t)((c) * 64 + row) * GLA_DK + ch * 8); kr[i] = *(const u32x4*)(ksrc + (size_t)((c) * 64 + row) * GLA_DK + ch * 8); } \
            if (tid < 256) { const int row = tid >> 2, ch = tid & 3; vr = *(const u32x4*)(vsrc + (size_t)((c) * 64 + row) * GLA_PP + ch * 8); } \
            else if (tid < 320) { dr = *(const u32x4*)(dsrc + (size_t)(c) * GLA_DK + (tid - 256) * 4); } } while (0)
#define GLA_SEQ_STORE() do { \
            _Pragma("unroll") for (int i = 0; i < 4; ++i) { const int id = tid + 512 * i, row = id >> 5, ch = id & 31; \
                *(LAS u32x4*)(Qt + row * QP + ch * 8) = qr[i]; *(LAS u32x4*)(Kh + row * KHP + ch * 8) = kr[i]; } \
            if (tid < 256) { const int row = tid >> 2, ch = tid & 3; *(LAS u32x4*)(Vt + row * VP + ch * 8) = vr; } \
            else if (tid < 320) { *(LAS u32x4*)(dec + (tid - 256) * 4) = dr; } } while (0)
        GLA_SEQ_LOAD(0);
        GLA_SEQ_STORE();
        __syncthreads();
        for (int c = 0; c < GLA_NC; ++c) {
            const int cur = c & 1;
            if (c + 1 < GLA_NC) GLA_SEQ_LOAD(c + 1);
            const LAS bf16_t* Sc = SBt + cur * 32 * QP; LAS bf16_t* Sn = SBt + (cur ^ 1) * 32 * QP;
            {
                const int vt = wave & 1, tt = wave >> 1; f32x4 acc = (f32x4){0.f, 0.f, 0.f, 0.f};
#pragma unroll
                for (int ks = 0; ks < 8; ++ks) acc = mma16(frag_rowk(Sc, QP, 16 * vt, 32 * ks, fr, fq), frag_rowk(Qt, QP, 16 * tt, 32 * ks, fr, fq), acc);
                { u32x2 w; w.x = cvtpk(acc[0], acc[1]); w.y = cvtpk(acc[2], acc[3]); *(LAS u32x2*)(Ost + (16 * tt + fr) * 32 + 16 * vt + 4 * fq) = w; }
            }
#pragma unroll
            for (int dl = 0; dl < 2; ++dl) { const f32x4 d4 = *(const LAS f32x4*)(dec + 16 * (2 * wave + dl) + 4 * fq);
#pragma unroll
                for (int vt = 0; vt < 2; ++vt) S[dl][vt] = S[dl][vt] * d4; }
#pragma unroll
            for (int ks = 0; ks < 2; ++ks) {
                bf16x8 bfr[2];
#pragma unroll
                for (int vt = 0; vt < 2; ++vt) bfr[vt] = frag_tr2(Vt, VP, 32 * ks + 4 * fq, 32 * ks + 16 + 4 * fq, 16 * vt, fr);
#pragma unroll
                for (int dl = 0; dl < 2; ++dl) { const bf16x8 af = frag_tr2(Kh, KHP, 32 * ks + 4 * fq, 32 * ks + 16 + 4 * fq, 16 * (2 * wave + dl), fr);
#pragma unroll
                    for (int vt = 0; vt < 2; ++vt) S[dl][vt] = mma16(af, bfr[vt], S[dl][vt]); }
            }
#pragma unroll
            for (int dl = 0; dl < 2; ++dl)
#pragma unroll
                for (int vt = 0; vt < 2; ++vt) { u32x2 w; w.x = cvtpk(S[dl][vt][0], S[dl][vt][1]); w.y = cvtpk(S[dl][vt][2], S[dl][vt][3]);
                    *(LAS u32x2*)(Sn + (16 * vt + fr) * QP + 16 * (2 * wave + dl) + 4 * fq) = w; }
            __syncthreads();
            if (c + 1 < GLA_NC) GLA_SEQ_STORE();
            if (tid < 256) *(u32x4*)(OI + ((((tb0 >> 6) + c) * 4 + h) * 16 + vs) * 2048 + tid * 8) = *(const LAS u32x4*)(Ost + tid * 8);
            __syncthreads();
        }
#undef GLA_SEQ_LOAD
#undef GLA_SEQ_STORE
    }
}

__device__ __forceinline__ void gla_post_phase(LAS unsigned char* lds, const bf16_t* QT, const bf16_t* KT  , const float* DEC, const bf16_t* proj, const bf16_t* OI, const float* gnorm, bf16_t* OG, int wg, int nwg, int tid) {
    const int lane = tid & 63, wave = __builtin_amdgcn_readfirstlane(tid >> 6), fr = lane & 15, fq = lane >> 4;
    constexpr int QP = 272, PP = 80, VP = 528;
    LAS bf16_t* Qt = (LAS bf16_t*)lds;
    LAS bf16_t* Kt = (LAS bf16_t*)(lds + 34816);
    LAS bf16_t* P = (LAS bf16_t*)(lds + 69632);
    LAS bf16_t* V = (LAS bf16_t*)(lds + 79872);
    LAS float* red = (LAS float*)(lds + 147456);
    for (int u = wg; u < NB * GLA_NC * GLA_H; u += nwg) {
        const int h = u & 3, bc = u >> 2; const size_t t0 = (size_t)bc * 64;
        float idc[8];
        { const float* dp = DEC + (size_t)bc * GLA_DK + h * 256 + (tid & 31) * 8; const f32x4 d0 = *(const f32x4*)dp, d1 = *(const f32x4*)(dp + 4);
          idc[0] = 1.0f / d0[0]; idc[1] = 1.0f / d0[1]; idc[2] = 1.0f / d0[2]; idc[3] = 1.0f / d0[3]; idc[4] = 1.0f / d1[0]; idc[5] = 1.0f / d1[1]; idc[6] = 1.0f / d1[2]; idc[7] = 1.0f / d1[3]; }
#pragma unroll
        for (int i = 0; i < 4; ++i) { const int id = tid + 512 * i, row = id >> 5, ch = id & 31;
            const u32x4 qv = *(const u32x4*)(QT + (t0 + row) * GLA_DK + h * 256 + ch * 8);
            u32x4 qs; qs.x = cvtpk(bflo(qv.x) * idc[0], bfhi(qv.x) * idc[1]); qs.y = cvtpk(bflo(qv.y) * idc[2], bfhi(qv.y) * idc[3]);
            qs.z = cvtpk(bflo(qv.z) * idc[4], bfhi(qv.z) * idc[5]); qs.w = cvtpk(bflo(qv.w) * idc[6], bfhi(qv.w) * idc[7]);
            *(LAS u32x4*)(Qt + row * QP + ch * 8) = qs;
            *(LAS u32x4*)(Kt + row * QP + ch * 8) = *(const u32x4*)(KT + (t0 + row) * GLA_DK + h * 256 + ch * 8); }
#pragma unroll
        for (int i = 0; i < 8; ++i) { const int id = tid + 512 * i, row = id >> 6, ch = id & 63;
            *(LAS u32x4*)(V + row * VP + ch * 8) = *(const u32x4*)(proj + (t0 + row) * GLA_PP + 2048 + h * 512 + ch * 8); }
        __syncthreads();
        {
            const int st_ = wave >> 1;
#pragma unroll
            for (int e = 0; e < 2; ++e) { const int tt = 2 * (wave & 1) + e; f32x4 acc = (f32x4){0.f, 0.f, 0.f, 0.f};
#pragma unroll
                for (int ks = 0; ks < 8; ++ks) acc = mma16(frag_rowk(Kt, QP, 16 * st_, 32 * ks, fr, fq), frag_rowk(Qt, QP, 16 * tt, 32 * ks, fr, fq), acc);
                const int t = 16 * tt + fr, s0 = 16 * st_ + 4 * fq;
                u32x2 w; w.x = cvtpk(s0 <= t ? acc[0] : 0.f, s0 + 1 <= t ? acc[1] : 0.f); w.y = cvtpk(s0 + 2 <= t ? acc[2] : 0.f, s0 + 3 <= t ? acc[3] : 0.f);
                *(LAS u32x2*)(P + t * PP + 32 * (st_ >> 1) + 8 * fq + 4 * (st_ & 1)) = w; }
        }
        __syncthreads();
        f32x4 acc[4][4];
#pragma unroll
        for (int vt = 0; vt < 4; ++vt)
#pragma unroll
            for (int tt = 0; tt < 4; ++tt) acc[vt][tt] = (f32x4){0.f, 0.f, 0.f, 0.f};
#pragma unroll
        for (int ks = 0; ks < 2; ++ks) {
            bf16x8 pb[4];
#pragma unroll
            for (int tt = 0; tt < 4; ++tt) pb[tt] = frag_rowk(P, PP, 16 * tt, 32 * ks, fr, fq);
#pragma unroll
            for (int vt = 0; vt < 4; ++vt) { const int cb = 64 * wave + 32 * (vt >> 1) + 8 * (fr & 3) + 4 * (vt & 1);
                const LAS bf16_t* pa = V + (32 * ks + 4 * fq + (fr >> 2)) * VP + cb;
                const s16x4 ta = __builtin_amdgcn_ds_read_tr16_b64_v4i16((LAS s16x4*)pa), tb2 = __builtin_amdgcn_ds_read_tr16_b64_v4i16((LAS s16x4*)(pa + 16 * VP));
                const bf16x8 af = (bf16x8){ta[0], ta[1], ta[2], ta[3], tb2[0], tb2[1], tb2[2], tb2[3]};
#pragma unroll
                for (int tt = 0; tt < 4; ++tt) acc[vt][tt] = mma16(af, pb[tt], acc[vt][tt]); }
        }
        float ss[4];
#pragma unroll
        for (int tt = 0; tt < 4; ++tt) { ss[tt] = 0.f;
#pragma unroll
            for (int P2 = 0; P2 < 2; ++P2) { const u32x4 oiw = *(const u32x4*)(OI + (((size_t)bc * 4 + h) * 16 + 2 * wave + P2) * 2048 + (16 * tt + fr) * 32 + 8 * fq);
                const f32x4 o0 = (f32x4){bflo(oiw.x), bfhi(oiw.x), bflo(oiw.y), bfhi(oiw.y)}, o1 = (f32x4){bflo(oiw.z), bfhi(oiw.z), bflo(oiw.w), bfhi(oiw.w)};
                acc[2 * P2][tt] = acc[2 * P2][tt] + o0; acc[2 * P2 + 1][tt] = acc[2 * P2 + 1][tt] + o1;
                const f32x4 a = acc[2 * P2][tt], c = acc[2 * P2 + 1][tt];
                ss[tt] += ((a[0] * a[0] + a[1] * a[1]) + (a[2] * a[2] + a[3] * a[3])) + ((c[0] * c[0] + c[1] * c[1]) + (c[2] * c[2] + c[3] * c[3])); }
            ss[tt] += __shfl_xor(ss[tt], 16); ss[tt] += __shfl_xor(ss[tt], 32);
            if (fq == 0) red[(16 * tt + fr) * 8 + wave] = ss[tt]; }
        __syncthreads();
#pragma unroll
        for (int tt = 0; tt < 4; ++tt) { const LAS f32x4* rp = (const LAS f32x4*)(red + (16 * tt + fr) * 8); const f32x4 r0 = rp[0], r1 = rp[1];
            const float tot = ((r0[0] + r0[1]) + (r0[2] + r0[3])) + ((r1[0] + r1[1]) + (r1[2] + r1[3]));
            const float rs = 1.0f / sqrtf(tot * (1.f / 512.f) + EPS); const size_t row = t0 + 16 * tt + fr;
#pragma unroll
            for (int P2 = 0; P2 < 2; ++P2) { const int v = 64 * wave + 32 * P2 + 8 * fq;
                const u32x4 rr = *(const u32x4*)(proj + row * GLA_PP + 4096 + h * 512 + v); const f32x4 g0 = *(const f32x4*)(gnorm + v), g1 = *(const f32x4*)(gnorm + v + 4);
                const f32x4 a = acc[2 * P2][tt], c = acc[2 * P2 + 1][tt];
                u32x4 w; w.x = cvtpk(a[0] * rs * g0[0] * pg8::silu_f(bflo(rr.x)), a[1] * rs * g0[1] * pg8::silu_f(bfhi(rr.x)));
                w.y = cvtpk(a[2] * rs * g0[2] * pg8::silu_f(bflo(rr.y)), a[3] * rs * g0[3] * pg8::silu_f(bfhi(rr.y)));
                w.z = cvtpk(c[0] * rs * g1[0] * pg8::silu_f(bflo(rr.z)), c[1] * rs * g1[1] * pg8::silu_f(bfhi(rr.z)));
                w.w = cvtpk(c[2] * rs * g1[2] * pg8::silu_f(bflo(rr.w)), c[3] * rs * g1[3] * pg8::silu_f(bfhi(rr.w)));
                *(u32x4*)(OG + row * DM + h * 512 + v) = w; } }
        __syncthreads();
    }
}

#define XB_TMO      128
#define XB_XCNT(j)  (256  + 64 * (j))
#define XB_XSUB(j)  (1280 + 64 * (j))
#define XB_XGEN(j)  (2304 + 64 * (j))
#define XB_TOP      3328
#define XB_TOPGEN   3392
#define XCD_BAR_WORDS 3456
#define XB_SPIN_CAP (1u << 18)

__device__ __forceinline__ unsigned xb_ld(unsigned* p)              { return __hip_atomic_load(p, __ATOMIC_RELAXED, __HIP_MEMORY_SCOPE_AGENT); }
__device__ __forceinline__ unsigned xb_add(unsigned* p, unsigned v) { return __hip_atomic_fetch_add(p, v, __ATOMIC_RELAXED, __HIP_MEMORY_SCOPE_AGENT); }
__device__ __forceinline__ unsigned xb_xcc_id() { return (unsigned)__builtin_amdgcn_s_getreg((3 << 11) | 20) & 0xFu; }
#define XB_SPIN(cond, bar) do { unsigned _sp = 0; while (cond) { __builtin_amdgcn_s_sleep(1); \
    if ((++_sp & 255u) == 0u) { if (xb_ld(&(bar)[XB_TMO])) break; if (_sp > XB_SPIN_CAP) { atomicAdd(&(bar)[XB_TMO], 1u); break; } } } } while (0)

struct XcdBarrier {
    unsigned* bar; unsigned x;
    volatile LAS unsigned* st;
};

__device__ __forceinline__ XcdBarrier xcd_barrier_post(unsigned* bar, volatile LAS unsigned* st) {
    XcdBarrier b; b.bar = bar; b.x = xb_xcc_id(); b.st = st;
    if (threadIdx.x == 0) (void)xb_add(&bar[XB_XCNT(b.x)], 1u);
    return b;
}
__device__ __forceinline__ void xcd_barrier_complete(unsigned* bar, unsigned x, unsigned& nloc, unsigned& nx) {
    const unsigned G = gridDim.x * gridDim.y * gridDim.z;
    unsigned sum, cnt, mine, sp = 0u;
    for (;;) {
        sum = 0u; cnt = 0u; mine = 0u;
#pragma unroll
        for (unsigned j = 0; j < 16; ++j) { const unsigned c = xb_ld(&bar[XB_XCNT(j)]); sum += c; cnt += (c > 0u) ? 1u : 0u; mine = (j == x) ? c : mine; }
        if (sum == G) break;
        __builtin_amdgcn_s_sleep(1);
        if ((++sp & 255u) == 0u) { if (xb_ld(&bar[XB_TMO])) break; if (sp > XB_SPIN_CAP) { atomicAdd(&bar[XB_TMO], 1u); break; } }
    }
    nloc = mine > 0u ? mine : 1u; nx = cnt > 0u ? cnt : 1u;
}

__device__ __forceinline__ void xcd_barrier(const XcdBarrier& b) {
    asm volatile("s_waitcnt vmcnt(0)" ::: "memory");
    __syncthreads();
    if (threadIdx.x == 0) {
        unsigned* bar = b.bar;
        __builtin_amdgcn_s_waitcnt(0);
        unsigned nloc = b.st[0], nx = b.st[1];
        if (nloc == 0u) { xcd_barrier_complete(bar, b.x, nloc, nx); b.st[0] = nloc; b.st[1] = nx; }
        const unsigned old = xb_add(&bar[XB_XSUB(b.x)], 1u);
        const unsigned gen = old / nloc;
        if (old + 1u == (gen + 1u) * nloc) {
            __builtin_amdgcn_fence(__ATOMIC_RELEASE, "agent");
            asm volatile("s_waitcnt vmcnt(0)" ::: "memory");
            const unsigned og = xb_add(&bar[XB_TOP], 1u);
            const unsigned tg = og / nx;
            if (og + 1u == (tg + 1u) * nx) xb_add(&bar[XB_TOPGEN], 1u);
            else XB_SPIN(xb_ld(&bar[XB_TOPGEN]) == tg, bar);
            __builtin_amdgcn_fence(__ATOMIC_ACQUIRE, "agent");
            xb_add(&bar[XB_XGEN(b.x)], 1u);
            asm volatile("s_waitcnt vmcnt(0)" ::: "memory");
        } else {
            XB_SPIN(xb_ld(&bar[XB_XGEN(b.x)]) == gen, bar);
            __builtin_amdgcn_fence(__ATOMIC_ACQUIRE, "agent");
            asm volatile("s_waitcnt vmcnt(0)" ::: "memory");
        }
    }
    __syncthreads();
}

#ifndef PMASK
#define PMASK 0xFFFF
#endif
#define PON(k) ((PMASK >> (k)) & 1)
#ifndef RMASK
#define RMASK 0
#endif
#define RPT(k) (((RMASK >> (k)) & 1) ? 2 : 1)
#define REP(k, body) for (int rp_ = 0; rp_ < RPT(k); ++rp_) { body; if (rp_ + 1 < RPT(k)) GSYNC(); }
__global__ void __launch_bounds__(NTHR) mega_fwd(Args a) {
    extern __shared__ __attribute__((aligned(16))) unsigned char lds_raw[];
    cg::grid_group grid = cg::this_grid();
    LAS unsigned char* lds = (LAS unsigned char*)lds_raw;
    const int G = gridDim.x, wg = blockIdx.x;
    const int ngw = G * NWAVES, ngt = G * NTHR;
    unsigned char* ws = a.ws;
    const float* x_in = a.in[0]; const float* norm_g = a.in[1];
    float* X = a.out;
    bf16_t* W_GLA_IN = (bf16_t*)(ws + WS_GLA_IN); bf16_t* W_GLA_OUT = (bf16_t*)(ws + WS_GLA_OUT); bf16_t* W_POOL = (bf16_t*)(ws + WS_POOL);
    bf16_t* W_DIFF_IN = (bf16_t*)(ws + WS_DIFF_IN); bf16_t* W_DIFF_OUT = (bf16_t*)(ws + WS_DIFF_OUT); bf16_t* W_GU = (bf16_t*)(ws + WS_GU); bf16_t* W_DOWN = (bf16_t*)(ws + WS_DOWN);
    bf16_t* HN = (bf16_t*)(ws + WS_HN); bf16_t* PROJ = (bf16_t*)(ws + WS_PROJ); bf16_t* HID = (bf16_t*)(ws + WS_HID);
    bf16_t* QT = (bf16_t*)(ws + WS_QT); bf16_t* KT = (bf16_t*)(ws + WS_KT); bf16_t* KH = (bf16_t*)(ws + WS_KH);
    bf16_t* XB = (bf16_t*)(ws + WS_XB); float* DEC = (float*)(ws + WS_DEC); bf16_t* OI = (bf16_t*)(ws + WS_OI); bf16_t* OG = (bf16_t*)(ws + WS_OG);
    const int lo = a.lo, hi = a.hi; int seam = 0; bool final_phase = false;
    volatile LAS unsigned* MISC = (volatile LAS unsigned*)(lds + MISC_OFF);
    if (threadIdx.x < 16) MISC[threadIdx.x] = 0u;
    __syncthreads();
    const XcdBarrier xbar = xcd_barrier_post((unsigned*)(ws + WS_BAR), MISC);
#define PH_BEGIN if (seam >= lo && seam < hi) { int tid = threadIdx.x; asm volatile("" : "+v"(tid)); const int lane = tid & 63, wave = __builtin_amdgcn_readfirstlane(tid >> 6); const int gw = wg * NWAVES + wave, gtid = wg * NTHR + tid; (void)lane; (void)gw; (void)gtid;
#define GSYNC() do { if (lo < 0) grid.sync(); xcd_barrier(xbar); } while (0)
#define PH_END   if (seam + 1 < hi && !final_phase) GSYNC(); } ++seam;

    PH_BEGIN
#if PON(0)
        for (int rp0 = 0; rp0 < RPT(0); ++rp0) {
        LAS float* scr = (LAS float*)(lds + wave * 17408);
        for (int s = 0; s < 2; ++s) {
            conv_matrix(a.in[2] + (size_t)s * DM * GLA_IN, DM, GLA_IN, GLA_INP, W_GLA_IN + (size_t)s * GLA_INP * DM, 0, scr, gw, ngw, lane);
            conv_matrix(a.in[6] + (size_t)s * DM * DM, DM, DM, DM, W_GLA_OUT + (size_t)s * DM * DM, 0, scr, gw, ngw, lane);
        }
        for (int g = 0; g < 4; ++g) conv_matrix(a.in[7] + (size_t)g * 512 * 512, 512, 512, 512, W_POOL + (size_t)g * 512 * 512, 0, scr, gw, ngw, lane, a.in[8] + g * 512);
        conv_matrix(a.in[9], DM, DIFF_IN, DIFF_IN, W_DIFF_IN, 0, scr, gw, ngw, lane);
        conv_matrix(a.in[14], DM, DM, DM, W_DIFF_OUT, 0, scr, gw, ngw, lane);
        for (int l = 0; l < 4; ++l) {
            conv_matrix(a.in[16] + (size_t)l * DM * 2 * FF, DM, 2 * FF, 2 * FF, W_GU + (size_t)l * 2 * FF * DM, 1, scr, gw, ngw, lane);
            conv_matrix(a.in[17] + (size_t)l * FF * DM, FF, DM, DM, W_DOWN + (size_t)l * DM * FF, 0, scr, gw, ngw, lane);
        }
        norm_phase(x_in, norm_g, HN, XB, gw, ngw, lane);
        if (rp0 + 1 < RPT(0)) grid.sync(); }
#endif
    PH_END

    for (int layer = 0; layer < 4; ++layer) {
        const int kind = layer % 3, slot = layer / 3;
        if (kind != 1) {
            PH_BEGIN
                const int N = (kind == 0) ? GLA_PP : DIFF_IN;
                pg8::Gemm g{HN, (kind == 0) ? W_GLA_IN + (size_t)slot * GLA_INP * DM : W_DIFF_IN, M, N, DM, DM, 0};
                pg8::StaticOrder S; S.init(M, N, G, wg);
                pg8::EpiStore E{PROJ, N};
#if PON(1)
                REP(1, (pg8::gemm_phase<pg8::EpiStore, pg8::StaticOrder, true, true>(lds, g, S, E)))
#endif
            PH_END
        }
        if (kind == 0) {
#if PON(2)
            PH_BEGIN REP(2, gla_pre_phase(lds, PROJ, HN, W_GLA_IN + (size_t)slot * GLA_INP * DM + (size_t)6144 * DM, a.in[3] + (size_t)slot * GLA_RANK * GLA_DK, a.in[4] + (size_t)slot * GLA_DK, QT, KT, KH, DEC, wg, G, tid)) PH_END
#endif
#if PON(3)
            PH_BEGIN REP(3, gla_seq_phase(lds, QT, KH, PROJ, DEC, OI, wg, G, tid)) PH_END
#endif
#if PON(4)
            PH_BEGIN REP(4, gla_post_phase(lds, QT, KH, DEC, PROJ, OI, a.in[5] + (size_t)slot * GLA_HV, OG, wg, G, tid)) PH_END
#endif
        } else if (kind == 1) {
#if PON(5)
            PH_BEGIN REP(5, pool_pre_phase(HN, OG, gtid, ngt)) PH_END
#endif
        } else {
#if PON(6)
            PH_BEGIN qknorm_phase(PROJ, a.in[10], a.in[11], gw, ngw, lane); PH_END
#endif
#if PON(7)
            PH_BEGIN REP(7, attn_phase(lds, PROJ, OG, a.in[12], a.in[13], a.in[15], a.in[10], wg, tid)) PH_END
#endif
        }
        for (int pass = 0; pass < 2; ++pass) {
            if (pass == 1) {
                PH_BEGIN REP(10, norm_phase_b(XB, norm_g + (size_t)(layer * 2 + 1) * DM, HN, gw, ngw, lane)) PH_END
                PH_BEGIN
                    pg8::Gemm g{HN, W_GU + (size_t)layer * 2 * FF * DM, M, 2 * FF, DM, DM, 0};
                    pg8::StaticOrder S; S.init(M, 2 * FF, G, wg);
                    pg8::EpiSwiglu E{HID, FF};
#if PON(8)
                    REP(8, (pg8::gemm_phase<pg8::EpiSwiglu, pg8::StaticOrder, true, true>(lds, g, S, E)))
#endif
                PH_END
            }
            PH_BEGIN
                pg8::Gemm g;
                if (pass == 1) g = pg8::Gemm{HID, W_DOWN + (size_t)layer * DM * FF, M, DM, FF, FF, 0};
                else if (kind == 0) g = pg8::Gemm{OG, W_GLA_OUT + (size_t)slot * DM * DM, M, DM, DM, DM, 0};
                else if (kind == 1) g = pg8::Gemm{OG, W_POOL, M, DM, 512, DM, 1};
                else g = pg8::Gemm{OG, W_DIFF_OUT, M, DM, DM, DM, 0};
                pg8::StaticOrder S; S.init(M, DM, G, wg, 4);
                const bool last_add = (layer == 3 && pass == 1); final_phase = last_add;
                pg8::EpiResid E{(const void*)XB, last_add ? (void*)X : (void*)XB, DM, last_add ? 1 : 0};
#if PON(9)
                pg8::gemm_phase<pg8::EpiResid, pg8::StaticOrder, true, true>(lds, g, S, E);
#endif
            PH_END
        }
        if (layer < 3) {
            PH_BEGIN REP(10, norm_phase_b(XB, norm_g + (size_t)((layer + 1) * 2) * DM, HN, gw, ngw, lane)) PH_END
        }
    }
#undef PH_BEGIN
#undef PH_END
}

extern "C" void kernel_launch(void* const* d_in, const int* in_sizes, int n_in, void* d_out, int out_size, void* d_ws, size_t ws_size, hipStream_t stream) {
    static int grid = 0;
    if (grid == 0) {
        if (n_in != 18 || out_size != M * DM || ws_size < WS_END) { fprintf(stderr, "kernel_launch: unexpected shapes (n_in %d out %d ws %zu)\n", n_in, out_size, ws_size); grid = -1; return; }
        int dev = 0, cus = 0, per_cu = 0;
        (void)hipGetDevice(&dev);
        (void)hipDeviceGetAttribute(&cus, hipDeviceAttributeMultiprocessorCount, dev);
        if (hipFuncSetAttribute((const void*)mega_fwd, hipFuncAttributeMaxDynamicSharedMemorySize, LDS_BYTES) != hipSuccess) { fprintf(stderr, "kernel_launch: hipFuncSetAttribute failed\n"); grid = -1; return; }
        if (hipOccupancyMaxActiveBlocksPerMultiprocessor(&per_cu, (const void*)mega_fwd, NTHR, LDS_BYTES) != hipSuccess || per_cu < 1) { fprintf(stderr, "kernel_launch: occupancy query says %d\n", per_cu); per_cu = 1; }
        (void)hipGetLastError();
        grid = cus * per_cu;
        if (grid != 256) { fprintf(stderr, "kernel_launch: built for a 256-workgroup grid (256 CUs x 1), got %d x %d\n", cus, per_cu); if (grid > 256) grid = 256; }
    }
    if (grid < 0) return;
    if (hipMemsetAsync((char*)d_ws + WS_BAR, 0, 16384, stream) != hipSuccess) { fprintf(stderr, "kernel_launch: memset of the barrier words failed\n"); return; }
    Args a{};
    for (int i = 0; i < 18; ++i) a.in[i] = (const float*)d_in[i];
    a.out = (float*)d_out; a.ws = (unsigned char*)d_ws; a.lo = 0; a.hi = 1 << 30;
    void* args[] = {&a};
    hipError_t e = hipLaunchCooperativeKernel((const void*)mega_fwd, dim3(grid), dim3(NTHR), args, LDS_BYTES, stream);
    if (e != hipSuccess) fprintf(stderr, "kernel_launch: cooperative launch failed: %s (grid %d)\n", hipGetErrorString(e), grid);
}
```

```cpp
#include <hip/hip_runtime.h>
#include <hip/hip_cooperative_groups.h>
#include <cstdio>
#include <cstdint>
namespace cg = cooperative_groups;

namespace pg8 {
#define PG8_LAS __attribute__((address_space(3)))
typedef unsigned short bf16_t;
typedef short bf16x8 __attribute__((ext_vector_type(8)));
typedef float f32x4 __attribute__((ext_vector_type(4)));
typedef unsigned u32x4 __attribute__((ext_vector_type(4)));
constexpr int BM = 256, BK = 64, HALF = 128, HTB = HALF * BK * 2, STAGE_BYTES = 8 * HTB, NXCD = 8, WGM = 8;

__host__ __device__ __forceinline__ int lds_byte(int r, int c) { const int st = (r >> 4) * 2 + (c >> 5), rr = r & 15, cc = c & 31, ob = rr * 64 + cc * 2; return st * 1024 + (ob ^ (((ob >> 9) & 1) << 5)); }
__host__ __device__ __forceinline__ void stage_rc(int b, int& R, int& C) { const int st = b / 1024, sb = b % 1024, swz = sb ^ (((sb >> 9) & 1) << 5); R = (st >> 1) * 16 + swz / 64; C = (st & 1) * 32 + (swz % 64) / 2; }
__host__ __device__ __forceinline__ int perm32(int rho) { const int n = rho >> 4, i = rho & 15; return 8 * (i >> 2) + 4 * n + (i & 3); }

struct Unit { int pm, pn; };
struct Gemm { const bf16_t* A; const bf16_t* Bt; int M, N, K, lda, agrp;
    __device__ __forceinline__ size_t aofs(int pn) const { return agrp ? (size_t)(pn >> 1) * 1024u : (size_t)0; } };

struct StaticOrder {
    int nM, nN, nwg, G, c, wgm;
    __host__ __device__ void init(int M, int N, int G_, int c_, int wgm_ = WGM) { nM = M / BM; nN = N / BM; nwg = nM * nN; G = G_; c = c_; wgm = wgm_; }
    __host__ __device__ bool next(int i, Unit& u) const {
        const long L = (long)i * G + c; if (L >= nwg) return false;
        int wgid = (int)L; { const int q = nwg / NXCD, r = nwg % NXCD, xcd = wgid % NXCD, off = wgid / NXCD; wgid = (xcd < r ? xcd * (q + 1) : r * (q + 1) + (xcd - r) * q) + off; }
        const int nig = wgm * nN, gid = wgid / nig, fm = gid * wgm, gsz = (nM - fm) < wgm ? (nM - fm) : wgm;
        u.pm = fm + ((wgid % nig) % gsz); u.pn = (wgid % nig) / gsz; return true;
    }
    __device__ __forceinline__ void a_ready(const Unit&) const {}
    __device__ __forceinline__ void done(const Unit&) const {}
};

typedef float f32x2_t __attribute__((ext_vector_type(2))); typedef __bf16 bf16x2_t __attribute__((ext_vector_type(2)));
__device__ __forceinline__ unsigned cvt_pk_bf16(float lo, float hi) { const f32x2_t v = {lo, hi}; const bf16x2_t b = __builtin_convertvector(v, bf16x2_t); return __builtin_bit_cast(unsigned, b); }

struct EpiStore {
    static constexpr bool PERM = true, AFTER_DRAIN = false;
    bf16_t* O; int ldc;
    __device__ __forceinline__ void init(f32x4 (&acc)[2][2][4][2], const Unit&, int, int, int, int) const {
#pragma unroll
        for (int a = 0; a < 2; ++a)
#pragma unroll
            for (int b = 0; b < 2; ++b)
#pragma unroll
                for (int m = 0; m < 4; ++m)
#pragma unroll
                    for (int n = 0; n < 2; ++n) acc[a][b][m][n] = (f32x4){0.f, 0.f, 0.f, 0.f};
    }
    __device__ __forceinline__ void operator()(const f32x4 (&acc)[2][2][4][2], const Unit& u, int wr, int wc, int fr, int fq) const {
        const int row0 = u.pm * BM + wr * 64 + fr; const int col0 = u.pn * BM + wc * 32 + 8 * fq;
#pragma unroll
        for (int ai = 0; ai < 2; ++ai)
#pragma unroll
            for (int m = 0; m < 4; ++m) { bf16_t* rowp = O + (size_t)(row0 + ai * HALF + m * 16) * ldc + col0;
#pragma unroll
                for (int bj = 0; bj < 2; ++bj) { const f32x4 v0 = acc[ai][bj][m][0], v1 = acc[ai][bj][m][1];
                    u32x4 w; w.x = cvt_pk_bf16(v0[0], v0[1]); w.y = cvt_pk_bf16(v0[2], v0[3]); w.z = cvt_pk_bf16(v1[0], v1[1]); w.w = cvt_pk_bf16(v1[2], v1[3]);
                    *(u32x4*)(rowp + bj * HALF) = w; } }
    }
};
__device__ __forceinline__ float silu_f(float g) { return g * __builtin_amdgcn_rcpf(1.0f + __expf(-g)); }
struct EpiSwiglu {
    static constexpr bool PERM = true, AFTER_DRAIN = false;
    bf16_t* O; int ldc;
    __device__ __forceinline__ void init(f32x4 (&acc)[2][2][4][2], const Unit&, int, int, int, int) const {
#pragma unroll
        for (int a = 0; a < 2; ++a)
#pragma unroll
            for (int b = 0; b < 2; ++b)
#pragma unroll
                for (int m = 0; m < 4; ++m)
#pragma unroll
                    for (int n = 0; n < 2; ++n) acc[a][b][m][n] = (f32x4){0.f, 0.f, 0.f, 0.f};
    }
    __device__ __forceinline__ void operator()(const f32x4 (&acc)[2][2][4][2], const Unit& u, int wr, int wc, int fr, int fq) const {
        const int row0 = u.pm * BM + wr * 64 + fr; const int col0 = u.pn * HALF + wc * 32 + 8 * fq;
#pragma unroll
        for (int ai = 0; ai < 2; ++ai)
#pragma unroll
            for (int m = 0; m < 4; ++m) { bf16_t* rowp = O + (size_t)(row0 + ai * HALF + m * 16) * ldc + col0;
                const f32x4 g0 = acc[ai][0][m][0], g1 = acc[ai][0][m][1], u0 = acc[ai][1][m][0], u1 = acc[ai][1][m][1];
                u32x4 w; w.x = cvt_pk_bf16(silu_f(g0[0]) * u0[0], silu_f(g0[1]) * u0[1]); w.y = cvt_pk_bf16(silu_f(g0[2]) * u0[2], silu_f(g0[3]) * u0[3]);
                w.z = cvt_pk_bf16(silu_f(g1[0]) * u1[0], silu_f(g1[1]) * u1[1]); w.w = cvt_pk_bf16(silu_f(g1[2]) * u1[2], silu_f(g1[3]) * u1[3]);
                *(u32x4*)rowp = w; asm volatile("" ::: "memory"); }
    }
};
struct EpiResid {
    static constexpr bool PERM = true, AFTER_DRAIN = false;
    const void* Xin; void* Xout; int ldc; int out_f32;
    __device__ __forceinline__ void init(f32x4 (&acc)[2][2][4][2], const Unit& u, int wr, int wc, int fr, int fq) const {
        const int row0 = u.pm * BM + wr * 64 + fr; const int col0 = u.pn * BM + wc * 32 + 8 * fq;
        { const bf16_t* xi = (const bf16_t*)Xin;
#pragma unroll
            for (int ai = 0; ai < 2; ++ai)
#pragma unroll
                for (int m = 0; m < 4; ++m)
#pragma unroll
                    for (int bj = 0; bj < 2; ++bj) { const u32x4 w = *(const u32x4*)(xi + (size_t)(row0 + ai * HALF + m * 16) * ldc + col0 + bj * HALF);
                        acc[ai][bj][m][0] = (f32x4){__uint_as_float(w.x << 16), __uint_as_float(w.x & 0xffff0000u), __uint_as_float(w.y << 16), __uint_as_float(w.y & 0xffff0000u)};
                        acc[ai][bj][m][1] = (f32x4){__uint_as_float(w.z << 16), __uint_as_float(w.z & 0xffff0000u), __uint_as_float(w.w << 16), __uint_as_float(w.w & 0xffff0000u)}; }
        }
    }
    __device__ __forceinline__ void operator()(const f32x4 (&acc)[2][2][4][2], const Unit& u, int wr, int wc, int fr, int fq) const {
        const int row0 = u.pm * BM + wr * 64 + fr; const int col0 = u.pn * BM + wc * 32 + 8 * fq;
        if (out_f32) { float* xo = (float*)Xout;
#pragma unroll
            for (int ai = 0; ai < 2; ++ai)
#pragma unroll
                for (int m = 0; m < 4; ++m)
#pragma unroll
                    for (int bj = 0; bj < 2; ++bj)
#pragma unroll
                        for (int n = 0; n < 2; ++n) *(f32x4*)(xo + (size_t)(row0 + ai * HALF + m * 16) * ldc + col0 + bj * HALF + 4 * n) = acc[ai][bj][m][n];
        } else { bf16_t* xo = (bf16_t*)Xout;
#pragma unroll
            for (int ai = 0; ai < 2; ++ai)
#pragma unroll
                for (int m = 0; m < 4; ++m)
#pragma unroll
                    for (int bj = 0; bj < 2; ++bj) { const f32x4 v0 = acc[ai][bj][m][0], v1 = acc[ai][bj][m][1];
                        u32x4 w; w.x = cvt_pk_bf16(v0[0], v0[1]); w.y = cvt_pk_bf16(v0[2], v0[3]); w.z = cvt_pk_bf16(v1[0], v1[1]); w.w = cvt_pk_bf16(v1[2], v1[3]);
                        *(u32x4*)(xo + (size_t)(row0 + ai * HALF + m * 16) * ldc + col0 + bj * HALF) = w; }
        }
    }
};

template <class Epi, class Sched, bool ALIGN_EPI = false, bool SP2 = false>
__device__ __forceinline__ void gemm_phase(PG8_LAS unsigned char* lds, const Gemm g, const Sched& S, const Epi& E) {
    int tid_o = threadIdx.x; asm volatile("" : "+v"(tid_o)); const int tid = tid_o, wid = __builtin_amdgcn_readfirstlane(tid >> 6), lane = tid & 63, wr = wid >> 2, wc = wid & 3, fr = lane & 15, fq = lane >> 4;
    const int K = g.K, nt = K / BK;
    unsigned voffA[2], voffB[2];
#pragma unroll
    for (int i = 0; i < 2; ++i) { int R, C; stage_rc(tid * 16 + i * 8192, R, C); const int Rb = Epi::PERM ? ((R & ~31) + perm32(R & 31)) : R;
        voffA[i] = (unsigned)(R * g.lda + C) * 2u; voffB[i] = (unsigned)(Rb * K + C) * 2u; }
    const size_t kstep = (size_t)(BK * 2);
    const size_t hstepA = (size_t)HALF * g.lda * 2, hstepB = (size_t)HALF * K * 2;
    const size_t tstepA = 2 * hstepA, tstepB = 2 * hstepB;
    const unsigned ldsw = (unsigned)wid * 1024u;
    const int aoff = lds_byte(wr * 64 + fr, fq * 8), boff = lds_byte(wc * 32 + fr, fq * 8);
#define PG8_SA(b, h) (((b) * 2 + (h)) * HTB)
#define PG8_SB(b, h) ((4 + (b) * 2 + (h)) * HTB)
#define PG8_STAGE(bufoff, gbase, voff) do { _Pragma("unroll") for (int _i = 0; _i < 2; ++_i) \
        __builtin_amdgcn_global_load_lds((const unsigned*)((const char*)(gbase) + (voff)[_i]), (PG8_LAS unsigned*)(lds + (bufoff) + ldsw + _i * 8192), 16, 0, 0); } while (0)
#define PG8_LDA(dst, b, h) do { _Pragma("unroll") for (int m = 0; m < 4; ++m) _Pragma("unroll") for (int k = 0; k < 2; ++k) dst[m][k] = *(const PG8_LAS bf16x8*)(lds + PG8_SA(b, h) + aoff + m * 2048 + k * 1024); } while (0)
#define PG8_LDB(dst, b, h) do { _Pragma("unroll") for (int n = 0; n < 2; ++n) _Pragma("unroll") for (int k = 0; k < 2; ++k) dst[n][k] = *(const PG8_LAS bf16x8*)(lds + PG8_SB(b, h) + boff + n * 2048 + k * 1024); } while (0)
#define PG8_MMA(ai, bj, At, Bt) do { __builtin_amdgcn_s_setprio(1); _Pragma("unroll") for (int m = 0; m < 4; ++m) _Pragma("unroll") for (int n = 0; n < 2; ++n) _Pragma("unroll") for (int k = 0; k < 2; ++k) \
        acc[ai][bj][m][n] = __builtin_amdgcn_mfma_f32_16x16x32_bf16(Bt[n][k], At[m][k], acc[ai][bj][m][n], 0, 0, 0); __builtin_amdgcn_s_setprio(0); } while (0)
#define PG8_WAIT_V(n) asm volatile("s_waitcnt vmcnt(" #n ")" ::: "memory")
#define PG8_WAIT_L(n) asm volatile("s_waitcnt lgkmcnt(" #n ")" ::: "memory")
#define PG8_BAR __builtin_amdgcn_s_barrier()
#define PG8_SCHED __builtin_amdgcn_sched_barrier(0)
    Unit cur, nxt; int ui = 0;
    if (!S.next(0, cur)) return;
    f32x4 acc[2][2][4][2];
    E.init(acc, cur, wr, wc, fr, fq);
    bf16x8 At[4][2], B0[2][2], B1[2][2];
    const char* cA = (const char*)g.A + (size_t)cur.pm * tstepA + g.aofs(cur.pn); const char* cB = (const char*)g.Bt + (size_t)cur.pn * tstepB;
    S.a_ready(cur);
    if constexpr (SP2) {
        PG8_STAGE(PG8_SB(0, 0), cB, voffB); PG8_STAGE(PG8_SB(0, 1), cB + hstepB, voffB); PG8_STAGE(PG8_SA(0, 0), cA, voffA); PG8_STAGE(PG8_SA(0, 1), cA + hstepA, voffA);
        if (wr == 1) PG8_BAR;
        PG8_WAIT_V(2); PG8_BAR;
        PG8_STAGE(PG8_SB(1, 0), cB + kstep, voffB); PG8_STAGE(PG8_SA(1, 0), cA + kstep, voffA); PG8_STAGE(PG8_SB(1, 1), cB + hstepB + kstep, voffB);
        PG8_WAIT_V(6); PG8_BAR;
    } else {
        PG8_STAGE(PG8_SB(0, 0), cB, voffB); PG8_STAGE(PG8_SA(0, 0), cA, voffA); PG8_STAGE(PG8_SB(0, 1), cB + hstepB, voffB); PG8_STAGE(PG8_SA(0, 1), cA + hstepA, voffA);
        if (wr == 1) PG8_BAR;
        PG8_WAIT_V(4); PG8_BAR;
        PG8_STAGE(PG8_SB(1, 0), cB + kstep, voffB); PG8_STAGE(PG8_SA(1, 0), cA + kstep, voffA); PG8_STAGE(PG8_SB(1, 1), cB + hstepB + kstep, voffB);
        PG8_WAIT_V(6); PG8_BAR;
    }
    for (;;) {
        const bool has_next = S.next(ui + 1, nxt);
        const char* nA = has_next ? (const char*)g.A + (size_t)nxt.pm * tstepA + g.aofs(nxt.pn) : cA; const char* nB = has_next ? (const char*)g.Bt + (size_t)nxt.pn * tstepB : cB;
        for (int t = 0; t < nt; t += 2) {
            const bool last = (t == nt - 2);
            const char* a1 = cA + (size_t)(t + 1) * kstep;
            const char* a2 = last ? nA : cA + (size_t)(t + 2) * kstep; const char* b2 = last ? nB : cB + (size_t)(t + 2) * kstep;
            const char* a3 = a2 + kstep; const char* b3 = b2 + kstep;
            if (last && has_next) S.a_ready(nxt);
            if constexpr (SP2) {
            PG8_LDB(B0, 0, 0); PG8_LDB(B1, 0, 1); PG8_SCHED; PG8_LDA(At, 0, 0); PG8_STAGE(PG8_SA(1, 1), a1 + hstepA, voffA);
            PG8_WAIT_V(8); PG8_WAIT_L(0); PG8_BAR; PG8_MMA(0, 0, At, B0); PG8_MMA(0, 1, At, B1); PG8_BAR; PG8_SCHED;
            PG8_LDA(At, 0, 1); PG8_STAGE(PG8_SB(0, 0), b2, voffB); PG8_STAGE(PG8_SB(0, 1), b2 + hstepB, voffB); PG8_STAGE(PG8_SA(0, 0), a2, voffA);
            PG8_WAIT_V(8); PG8_WAIT_L(0); PG8_BAR; PG8_MMA(1, 0, At, B0); PG8_MMA(1, 1, At, B1); PG8_BAR; PG8_SCHED;
            PG8_LDB(B0, 1, 0); PG8_LDB(B1, 1, 1); PG8_SCHED; PG8_LDA(At, 1, 0); PG8_STAGE(PG8_SA(0, 1), a2 + hstepA, voffA);
            PG8_WAIT_V(8); PG8_WAIT_L(0); PG8_BAR; PG8_MMA(0, 0, At, B0); PG8_MMA(0, 1, At, B1); PG8_BAR; PG8_SCHED;
            PG8_LDA(At, 1, 1); PG8_STAGE(PG8_SB(1, 0), b3, voffB); PG8_STAGE(PG8_SB(1, 1), b3 + hstepB, voffB); PG8_STAGE(PG8_SA(1, 0), a3, voffA);
            PG8_WAIT_V(8); PG8_WAIT_L(0); PG8_BAR; PG8_MMA(1, 0, At, B0); PG8_MMA(1, 1, At, B1); PG8_BAR; PG8_SCHED;
            } else {
            PG8_LDB(B0, 0, 0); PG8_SCHED; PG8_LDA(At, 0, 0); PG8_STAGE(PG8_SA(1, 1), a1 + hstepA, voffA);
            PG8_WAIT_L(8); PG8_BAR; PG8_WAIT_L(0); PG8_MMA(0, 0, At, B0); PG8_BAR; PG8_SCHED;
            PG8_LDB(B1, 0, 1); PG8_STAGE(PG8_SB(0, 0), b2, voffB);
            PG8_BAR; PG8_WAIT_L(0); PG8_MMA(0, 1, At, B1); PG8_BAR;
            PG8_LDA(At, 0, 1); PG8_STAGE(PG8_SA(0, 0), a2, voffA);
            PG8_BAR; PG8_WAIT_L(0); PG8_MMA(1, 0, At, B0); PG8_BAR; PG8_SCHED;
            PG8_STAGE(PG8_SB(0, 1), b2 + hstepB, voffB);
            PG8_WAIT_V(6); PG8_BAR; PG8_MMA(1, 1, At, B1); PG8_BAR;
            PG8_LDB(B0, 1, 0); PG8_SCHED; PG8_LDA(At, 1, 0); PG8_STAGE(PG8_SA(0, 1), a2 + hstepA, voffA);
            PG8_WAIT_L(8); PG8_BAR; PG8_WAIT_L(0); PG8_MMA(0, 0, At, B0); PG8_BAR; PG8_SCHED;
            PG8_LDB(B1, 1, 1); PG8_STAGE(PG8_SB(1, 0), b3, voffB);
            PG8_BAR; PG8_WAIT_L(0); PG8_MMA(0, 1, At, B1); PG8_BAR;
            PG8_LDA(At, 1, 1); PG8_STAGE(PG8_SA(1, 0), a3, voffA);
            PG8_BAR; PG8_WAIT_L(0); PG8_MMA(1, 0, At, B0); PG8_BAR; PG8_SCHED;
            PG8_STAGE(PG8_SB(1, 1), b3 + hstepB, voffB);
            PG8_WAIT_V(6); PG8_BAR; PG8_MMA(1, 1, At, B1); PG8_BAR;
            }
        }
        if constexpr (ALIGN_EPI) { if (wr == 0) PG8_BAR; }
        if constexpr (!Epi::AFTER_DRAIN) { E(acc, cur, wr, wc, fr, fq); S.done(cur); }
        if (!has_next) break;
        E.init(acc, nxt, wr, wc, fr, fq);
        cur = nxt; cA = nA; cB = nB; ++ui;
        if constexpr (ALIGN_EPI) { if (wr == 1) PG8_BAR; }
    }
    PG8_WAIT_V(0);
    if constexpr (!ALIGN_EPI) { if (wr == 0) PG8_BAR; }
    PG8_BAR;
    if constexpr (Epi::AFTER_DRAIN) { E.fused(acc, cur, wr, wc, fr, fq, lds, wid, lane); S.done(cur); }
#undef PG8_SA
#undef PG8_SB
#undef PG8_STAGE
#undef PG8_LDA
#undef PG8_LDB
#undef PG8_MMA
#undef PG8_WAIT_V
#undef PG8_WAIT_L
#undef PG8_BAR
#undef PG8_SCHED
}}

constexpr int NB = 4, SEQ = 4096, DM = 2048, M = NB * SEQ;
constexpr int GLA_H = 4, GLA_DK = 1024, GLA_DV = 2048, GLA_HK = 256, GLA_HV = 512, GLA_RANK = 16, GLA_C = 64, GLA_NC = SEQ / GLA_C, GLA_IN = 6160, GLA_INP = 6400  , GLA_PP = 6144  ;
constexpr int FF = 5632, DIFF_IN = 6144;
constexpr float EPS = 1e-6f, LOG2E = 1.4426950408889634f;
constexpr float LAM_INIT = 0.47071302f;
constexpr float QSCALE = 0.08838834764831845f * LOG2E;

constexpr size_t MiB = 1u << 20;
constexpr size_t WS_GLA_IN = 0;
constexpr size_t WS_GLA_OUT = 50 * MiB;
constexpr size_t WS_POOL = 66 * MiB;
constexpr size_t WS_DIFF_IN = 68 * MiB;
constexpr size_t WS_DIFF_OUT = 92 * MiB;
constexpr size_t WS_GU = 100 * MiB;
constexpr size_t WS_DOWN = 276 * MiB;
constexpr size_t WS_HN = 364 * MiB;
constexpr size_t WS_PROJ = 428 * MiB;
constexpr size_t WS_HID = 628 * MiB;
constexpr size_t WS_QT = 804 * MiB, WS_KT = 836 * MiB, WS_KH = 868 * MiB;
constexpr size_t WS_DEC = 900 * MiB;
constexpr size_t WS_OI = 901 * MiB;
constexpr size_t WS_OG = 1029 * MiB;
constexpr size_t WS_BAR = 1093 * MiB;
constexpr size_t WS_XB = 1094 * MiB;
constexpr size_t WS_END = 1158 * MiB;

constexpr int MISC_OFF = 152576;
constexpr int LDS_BYTES = 155648;
constexpr int NWAVES = 8, NTHR = 512;

#define LAS __attribute__((address_space(3)))
typedef unsigned short bf16_t;
typedef short bf16x8 __attribute__((ext_vector_type(8)));
typedef short s16x4 __attribute__((ext_vector_type(4)));
typedef float f32x4 __attribute__((ext_vector_type(4)));
typedef float f32x2 __attribute__((ext_vector_type(2)));
typedef unsigned u32x4 __attribute__((ext_vector_type(4)));
typedef unsigned u32x2 __attribute__((ext_vector_type(2)));

__device__ __forceinline__ unsigned cvtpk(float lo, float hi) { return pg8::cvt_pk_bf16(lo, hi); }
__device__ __forceinline__ float bflo(unsigned u) { return __uint_as_float(u << 16); }
__device__ __forceinline__ float bfhi(unsigned u) { return __uint_as_float(u & 0xffff0000u); }
__device__ __forceinline__ float bf2f(bf16_t u) { return __uint_as_float((unsigned)u << 16); }
__device__ __forceinline__ float wave_sum(float v) {
#pragma unroll
    for (int o = 1; o < 64; o <<= 1) v += __shfl_xor(v, o);
    return v;
}
__device__ __forceinline__ f32x4 mma16(bf16x8 a, bf16x8 b, f32x4 c) { return __builtin_amdgcn_mfma_f32_16x16x32_bf16(a, b, c, 0, 0, 0); }
__device__ __forceinline__ bf16x8 frag_rowk(const LAS bf16_t* T, int pitch, int r0, int k0, int fr, int fq) {
    return *(const LAS bf16x8*)(T + (r0 + fr) * pitch + k0 + 8 * fq);
}
__device__ __forceinline__ bf16x8 frag_tr2(const LAS bf16_t* T, int pitch, int rowA, int rowB, int c0, int fr) {
    const LAS bf16_t* pa = T + (rowA + (fr >> 2)) * pitch + c0 + 4 * (fr & 3);
    const LAS bf16_t* pb = T + (rowB + (fr >> 2)) * pitch + c0 + 4 * (fr & 3);
    const s16x4 a = __builtin_amdgcn_ds_read_tr16_b64_v4i16((LAS s16x4*)pa);
    const s16x4 b = __builtin_amdgcn_ds_read_tr16_b64_v4i16((LAS s16x4*)pb);
    return (bf16x8){a[0], a[1], a[2], a[3], b[0], b[1], b[2], b[3]};
}
__device__ __forceinline__ bf16x8 frag_tr(const LAS bf16_t* T, int pitch, int k0, int c0, int fr, int fq) { return frag_tr2(T, pitch, k0 + 8 * fq, k0 + 8 * fq + 4, c0, fr); }

struct Args { const float* in[18]; float* out; unsigned char* ws; int lo, hi; };

__device__ __forceinline__ void conv_matrix(const float* W, int K, int N, int Nv, bf16_t* WT, int mode, LAS float* scr, int gw, int ngw, int lane, const float* nscale = nullptr) {
    const int nblk = Nv / 64, nitems = (K / 64) * nblk;
    const int r4 = lane >> 4, c4 = (lane & 15) * 4;
    for (int it = gw; it < nitems; it += ngw) {
        const int kb = it / nblk, nb = it % nblk, k0 = 64 * kb, n0 = 64 * nb;
        const bool ok = (n0 + c4) < N;
        const float* src = W + (size_t)(k0 + r4) * N + n0 + c4;
        f32x4 v[16];
#pragma unroll
        for (int i = 0; i < 16; ++i) v[i] = ok ? *(const f32x4*)(src + (size_t)(4 * i) * N) : (f32x4){0.f, 0.f, 0.f, 0.f};
        if (nscale) { const f32x4 s4 = *(const f32x4*)(nscale + n0 + c4);
#pragma unroll
            for (int i = 0; i < 16; ++i) v[i] = v[i] * s4; }
#pragma unroll
        for (int i = 0; i < 16; ++i) { LAS float* q = scr + (4 * i + r4) * 65 + c4; q[0] = v[i][0]; q[1] = v[i][1]; q[2] = v[i][2]; q[3] = v[i][3]; }
        asm volatile("s_waitcnt lgkmcnt(0)" ::: "memory");
        int d0 = n0;
        if (mode == 1) { d0 = (n0 < FF) ? (256 * (n0 / 128) + (n0 % 128)) : (256 * ((n0 - FF) / 128) + 128 + ((n0 - FF) % 128)); }
        const int ns = lane >> 3, c = lane & 7;
        bf16_t* dst = WT + (size_t)(d0 + ns) * K + k0 + 8 * c;
        const LAS float* sp = scr + (8 * c) * 65 + ns;
#pragma unroll
        for (int i = 0; i < 8; ++i) { u32x4 o;
            o.x = cvtpk(sp[8 * i + 0 * 65], sp[8 * i + 1 * 65]); o.y = cvtpk(sp[8 * i + 2 * 65], sp[8 * i + 3 * 65]);
            o.z = cvtpk(sp[8 * i + 4 * 65], sp[8 * i + 5 * 65]); o.w = cvtpk(sp[8 * i + 6 * 65], sp[8 * i + 7 * 65]);
            *(u32x4*)(dst + (size_t)(8 * i) * K) = o; }
        asm volatile("s_waitcnt lgkmcnt(0)" ::: "memory");
    }
}

template <int NR>
__device__ __forceinline__ void norm_rows(const float* xrow, const float* g, bf16_t* orow, bf16_t* crow, int lane) {
    f32x4 v[NR][8]; float s[NR];
#pragma unroll
    for (int r = 0; r < NR; ++r) { const f32x4* xr = (const f32x4*)(xrow + (size_t)r * DM) + lane;
#pragma unroll
        for (int j = 0; j < 8; ++j) v[r][j] = xr[64 * j]; }
#pragma unroll
    for (int r = 0; r < NR; ++r) { s[r] = 0.f;
#pragma unroll
        for (int j = 0; j < 8; ++j) s[r] += (v[r][j].x * v[r][j].x + v[r][j].y * v[r][j].y) + (v[r][j].z * v[r][j].z + v[r][j].w * v[r][j].w);
        s[r] = 1.0f / sqrtf(wave_sum(s[r]) * (1.f / DM) + EPS); }
#pragma unroll
    for (int j = 0; j < 8; ++j) { const f32x4 gg = *((const f32x4*)g + lane + 64 * j);
#pragma unroll
        for (int r = 0; r < NR; ++r) { u32x2 w; w.x = cvtpk(v[r][j].x * s[r] * gg.x, v[r][j].y * s[r] * gg.y); w.y = cvtpk(v[r][j].z * s[r] * gg.z, v[r][j].w * s[r] * gg.w);
            *((u32x2*)(orow + (size_t)r * DM) + lane + 64 * j) = w;
            u32x2 c; c.x = cvtpk(v[r][j].x, v[r][j].y); c.y = cvtpk(v[r][j].z, v[r][j].w); *((u32x2*)(crow + (size_t)r * DM) + lane + 64 * j) = c; } }
}
template <int NR>
__device__ __forceinline__ void norm_rows_b(const bf16_t* xrow, const float* g, bf16_t* orow, int lane) {
    u32x4 v[NR][4]; float s[NR];
#pragma unroll
    for (int r = 0; r < NR; ++r) { const u32x4* xr = (const u32x4*)(xrow + (size_t)r * DM) + lane;
#pragma unroll
        for (int j = 0; j < 4; ++j) v[r][j] = xr[64 * j]; }
#pragma unroll
    for (int r = 0; r < NR; ++r) { s[r] = 0.f;
#pragma unroll
        for (int j = 0; j < 4; ++j)
#pragma unroll
            for (int e = 0; e < 4; ++e) { const float a = bflo(v[r][j][e]), c = bfhi(v[r][j][e]); s[r] += a * a + c * c; }
        s[r] = 1.0f / sqrtf(wave_sum(s[r]) * (1.f / DM) + EPS); }
#pragma unroll
    for (int j = 0; j < 4; ++j) { const f32x4 g0 = *((const f32x4*)g + 2 * (lane + 64 * j)), g1 = *((const f32x4*)g + 2 * (lane + 64 * j) + 1);
#pragma unroll
        for (int r = 0; r < NR; ++r) { u32x4 w;
            w.x = cvtpk(bflo(v[r][j].x) * s[r] * g0[0], bfhi(v[r][j].x) * s[r] * g0[1]); w.y = cvtpk(bflo(v[r][j].y) * s[r] * g0[2], bfhi(v[r][j].y) * s[r] * g0[3]);
            w.z = cvtpk(bflo(v[r][j].z) * s[r] * g1[0], bfhi(v[r][j].z) * s[r] * g1[1]); w.w = cvtpk(bflo(v[r][j].w) * s[r] * g1[2], bfhi(v[r][j].w) * s[r] * g1[3]);
            *((u32x4*)(orow + (size_t)r * DM) + lane + 64 * j) = w; } }
}
__device__ __forceinline__ void norm_phase(const float* x, const float* g, bf16_t* hn, bf16_t* cp, int gw, int ngw, int lane) {
#pragma unroll 1
    for (int m = gw * 2; m < M; m += ngw * 2) norm_rows<2>(x + (size_t)m * DM, g, hn + (size_t)m * DM, cp + (size_t)m * DM, lane);
}
__device__ __forceinline__ void norm_phase_b(const bf16_t* x, const float* g, bf16_t* hn, int gw, int ngw, int lane) {
#pragma unroll 1
    for (int m = gw * 2; m < M; m += ngw * 2) norm_rows_b<2>(x + (size_t)m * DM, g, hn + (size_t)m * DM, lane);
}

__device__ __forceinline__ void pool_pre_phase(const bf16_t* hn, bf16_t* yp, int gtid, int ngt) {
    for (int idx = gtid; idx < NB * (SEQ / 64) * (DM / 2); idx += ngt) {
        const int cp = idx & 1023, run = idx >> 10, col = cp * 2, g = col >> 9, w = 2 << g;
        const int tr0 = (run & 63) * 64;
        const size_t row0 = (size_t)run * 64;
        const bf16_t* p = hn + row0 * DM + col;
        float r0[16], r1[16]; float s0 = 0.f, s1 = 0.f;
#pragma unroll
        for (int i = 0; i < 16; ++i) { r0[i] = 0.f; r1[i] = 0.f; }
        if (tr0 > 0) {
#pragma unroll
            for (int i = 1; i < 16; ++i) { const unsigned v = *(const unsigned*)(p - (size_t)(16 - i) * DM); r0[i] = bflo(v); r1[i] = bfhi(v);
                if (16 - i <= w) { s0 += r0[i]; s1 += r1[i]; } }
        }
        for (int tb = 0; tb < 64; tb += 16) {
#pragma unroll
            for (int i = 0; i < 16; ++i) { const int t = tb + i; const unsigned v = *(const unsigned*)(p + (size_t)t * DM);
                const float n0 = bflo(v), n1 = bfhi(v);
                const float o0 = r0[(i + 16 - w) & 15], o1 = r1[(i + 16 - w) & 15];
                s0 += n0 - o0; s1 += n1 - o1; r0[i] = n0; r1[i] = n1;
                const int cnt = (tr0 + t + 1 < w) ? (tr0 + t + 1) : w; const float inv = 1.0f / (float)cnt;
                *(unsigned*)(yp + (row0 + t) * DM + col) = cvtpk(s0 * inv - n0, s1 * inv - n1); }
        }
    }
}

__device__ __forceinline__ void qknorm_phase(bf16_t* proj, const float* qg, const float* kg, int gw, int ngw, int lane) {
    const int sub = lane >> 4, l16 = lane & 15;
    constexpr int NIT = M * 16 / 4, U = 4;
    for (int it0 = gw * U; it0 < NIT; it0 += ngw * U) {
        u32x4 v[U]; bf16_t* p[U];
#pragma unroll
        for (int u = 0; u < U; ++u) { const int G = (it0 + u) * 4 + sub, row = G >> 4, hd = 16 + (G & 15); p[u] = proj + (size_t)row * DIFF_IN + hd * 128 + l16 * 8; v[u] = *(const u32x4*)p[u]; }
#pragma unroll
        for (int u = 0; u < U; ++u) { const int hd = 16 + (((it0 + u) * 4 + sub) & 15);
            float f[8]; float ss = 0.f;
#pragma unroll
            for (int e = 0; e < 4; ++e) { f[2 * e] = bflo(v[u][e]); f[2 * e + 1] = bfhi(v[u][e]); ss += f[2 * e] * f[2 * e] + f[2 * e + 1] * f[2 * e + 1]; }
            ss += __shfl_xor(ss, 1); ss += __shfl_xor(ss, 2); ss += __shfl_xor(ss, 4); ss += __shfl_xor(ss, 8);
            const float rs = (1.0f / sqrtf(ss * (1.f / 128.f) + EPS)) * (hd < 16 ? QSCALE : 1.0f);
            const float* gp = (hd < 16 ? qg : kg) + l16 * 8;
            const f32x4 g0 = *(const f32x4*)gp, g1 = *(const f32x4*)(gp + 4);
            u32x4 o; o.x = cvtpk(f[0] * rs * g0.x, f[1] * rs * g0.y); o.y = cvtpk(f[2] * rs * g0.z, f[3] * rs * g0.w);
            o.z = cvtpk(f[4] * rs * g1.x, f[5] * rs * g1.y); o.w = cvtpk(f[6] * rs * g1.z, f[7] * rs * g1.w);
            *(u32x4*)p[u] = o; }
    }
}

__device__ __forceinline__ void attn_phase(LAS unsigned char* lds, const bf16_t* proj, bf16_t* oa, const float* lamp, const float* subg, const float* relb, const float* qg, int wg, int tid) {
    const int lane = tid & 63, wave = __builtin_amdgcn_readfirstlane(tid >> 6), fr = lane & 15, fq = lane >> 4;
    constexpr int KP = 144, VP = 272, KB_BUF = 2 * 32 * KP, VB_BUF = 32 * VP;
    LAS bf16_t* Kb = (LAS bf16_t*)lds;
    LAS bf16_t* Vb = (LAS bf16_t*)(lds + 2 * KB_BUF * 2);
    LAS float* tb = (LAS float*)(lds + 2 * KB_BUF * 2 + 2 * VB_BUF * 2);
    LAS bf16_t* Qs = (LAS bf16_t*)(lds + 2 * KB_BUF * 2 + 2 * VB_BUF * 2 + 2048);
    float lam;
    { const float s1 = lamp[lane] * lamp[128 + lane] + lamp[64 + lane] * lamp[192 + lane];
      const float s2 = lamp[256 + lane] * lamp[384 + lane] + lamp[320 + lane] * lamp[448 + lane];
      lam = expf(wave_sum(s1)) - expf(wave_sum(s2)) + LAM_INIT; }
    const int xj = wg >> 3, bh = (wg & 7) * 4 + (xj >> 3), b = bh >> 3, h = bh & 7, sx = xj & 7;
    const size_t rb = (size_t)b * SEQ;
    const bf16_t* ksrc = proj + rb * DIFF_IN + 2048 + (2 * h) * 128;
    const bf16_t* vsrc = proj + rb * DIFF_IN + 4096 + h * 256;
    if (tid < 258) { const int sub = tid >= 129 ? 1 : 0, rel = tid - 129 * sub; int bucket;
        if (rel < 16) bucket = rel; else if (rel >= 128) bucket = 31;
        else { bucket = 16 + (int)(logf((float)rel / 16.0f) / 2.0794415416798357f * 16.0f); if (bucket > 31) bucket = 31; }
        tb[sub * 132 + rel] = relb[bucket * 16 + 2 * h + sub] * LOG2E; }
    const float c31a = relb[31 * 16 + 2 * h] * LOG2E, c31b = relb[31 * 16 + 2 * h + 1] * LOG2E;
    for (int ui = 0; ui < 4; ++ui) {
        const int qb = (ui == 0) ? sx : (ui == 1) ? 15 - sx : (ui == 2) ? 16 + sx : 31 - sx;
        const int q0 = qb * 128, qw0 = q0 + wave * 16, nkt = (q0 + 128) / 32;
        LAS bf16_t* Qw = Qs + wave * (2 * 16 * KP);
#pragma unroll
        for (int s = 0; s < 2; ++s) { u32x4 qc[4]; float ss = 0.f;
#pragma unroll
            for (int ks = 0; ks < 4; ++ks) { qc[ks] = *(const u32x4*)(proj + (rb + qw0 + fr) * DIFF_IN + (2 * h + s) * 128 + 32 * ks + 8 * fq);
#pragma unroll
                for (int e = 0; e < 4; ++e) { const float a = bflo(qc[ks][e]), c = bfhi(qc[ks][e]); ss += a * a + c * c; } }
            ss += __shfl_xor(ss, 16); ss += __shfl_xor(ss, 32);
            const float rs = (1.0f / sqrtf(ss * (1.f / 128.f) + EPS)) * QSCALE;
#pragma unroll
            for (int ks = 0; ks < 4; ++ks) { const f32x4 g0 = *(const f32x4*)(qg + 32 * ks + 8 * fq), g1 = *(const f32x4*)(qg + 32 * ks + 8 * fq + 4);
                u32x4 o; o.x = cvtpk(bflo(qc[ks].x) * rs * g0[0], bfhi(qc[ks].x) * rs * g0[1]); o.y = cvtpk(bflo(qc[ks].y) * rs * g0[2], bfhi(qc[ks].y) * rs * g0[3]);
                o.z = cvtpk(bflo(qc[ks].z) * rs * g1[0], bfhi(qc[ks].z) * rs * g1[1]); o.w = cvtpk(bflo(qc[ks].w) * rs * g1[2], bfhi(qc[ks].w) * rs * g1[3]);
                *(LAS u32x4*)(Qw + (s * 16 + fr) * KP + 32 * ks + 8 * fq) = o; } }
#pragma unroll
        for (int i = 0; i < 2; ++i) { const int id = tid + 512 * i, s = id >> 9, row = (id >> 4) & 31, ch = id & 15;
            *(LAS u32x4*)(Kb + (s * 32 + row) * KP + ch * 8) = *(const u32x4*)(ksrc + (size_t)row * DIFF_IN + s * 128 + ch * 8); }
#pragma unroll
        for (int i = 0; i < 2; ++i) { const int id = tid + 512 * i, row = id >> 5, ch = id & 31;
            *(LAS u32x4*)(Vb + row * VP + ch * 8) = *(const u32x4*)(vsrc + (size_t)row * DIFF_IN + ch * 8); }
        __syncthreads();
        float l0 = 0.f, l1 = 0.f;
        f32x4 o[2][16];
#pragma unroll
        for (int s = 0; s < 2; ++s)
#pragma unroll
            for (int vt = 0; vt < 16; ++vt) o[s][vt] = (f32x4){0.f, 0.f, 0.f, 0.f};
        for (int kt = 0; kt < nkt; ++kt) {
            const int cur = kt & 1, k0 = kt * 32; const bool more = kt + 1 < nkt;
            u32x4 kr[2], vr[2];
            if (more) {
#pragma unroll
                for (int i = 0; i < 2; ++i) { const int id = tid + 512 * i, s = id >> 9, row = (id >> 4) & 31, ch = id & 15; kr[i] = *(const u32x4*)(ksrc + (size_t)(k0 + 32 + row) * DIFF_IN + s * 128 + ch * 8); }
#pragma unroll
                for (int i = 0; i < 2; ++i) { const int id = tid + 512 * i, row = id >> 5, ch = id & 31; vr[i] = *(const u32x4*)(vsrc + (size_t)(k0 + 32 + row) * DIFF_IN + ch * 8); }
            }
            if (k0 <= qw0 + 15) {
                const LAS bf16_t* Kc = Kb + cur * KB_BUF; const LAS bf16_t* Vc = Vb + cur * VB_BUF;
                const bool far = (qw0 - (k0 + 31)) >= 128;
                f32x4 st[2][2];
                int qoff = (fr * KP + 8 * fq); asm volatile("" : "+v"(qoff));
#pragma unroll
                for (int s = 0; s < 2; ++s) { const float ini = far ? (s ? c31b : c31a) : 0.f;
                    st[s][0] = (f32x4){ini, ini, ini, ini}; st[s][1] = st[s][0];
#pragma unroll
                    for (int ks = 0; ks < 4; ++ks) { const bf16x8 qfr = *(const LAS bf16x8*)(Qw + s * 16 * KP + qoff + 32 * ks);
#pragma unroll
                        for (int T = 0; T < 2; ++T) st[s][T] = mma16(frag_rowk(Kc + s * 32 * KP, KP, 16 * T, 32 * ks, fr, fq), qfr, st[s][T]); } }
                if (!far) {
#pragma unroll
                    for (int T = 0; T < 2; ++T)
#pragma unroll
                        for (int r = 0; r < 4; ++r) { const int rel = qw0 + fr - (k0 + 16 * T + 4 * fq + r); const int ri = rel < 0 ? 0 : (rel > 128 ? 128 : rel);
                            const float b0 = tb[ri], b1 = tb[132 + ri];
                            st[0][T][r] = rel < 0 ? -INFINITY : st[0][T][r] + b0; st[1][T][r] = rel < 0 ? -INFINITY : st[1][T][r] + b1; }
                }
                bf16x8 pf[2];
#pragma unroll
                for (int s = 0; s < 2; ++s) { float ps = 0.f;
#pragma unroll
                    for (int T = 0; T < 2; ++T)
#pragma unroll
                        for (int r = 0; r < 4; ++r) { const float p = __builtin_amdgcn_exp2f(st[s][T][r]); st[s][T][r] = p; ps += p; }
                    if (s == 0) l0 += ps; else l1 += ps;
                    u32x4 w; w.x = cvtpk(st[s][0][0], st[s][0][1]); w.y = cvtpk(st[s][0][2], st[s][0][3]); w.z = cvtpk(st[s][1][0], st[s][1][1]); w.w = cvtpk(st[s][1][2], st[s][1][3]);
                    pf[s] = __builtin_bit_cast(bf16x8, w); }
#pragma unroll
                for (int vt = 0; vt < 16; ++vt) { const bf16x8 vf = frag_tr2(Vc, VP, 4 * fq, 16 + 4 * fq, 16 * vt, fr);
                    o[0][vt] = mma16(vf, pf[0], o[0][vt]); o[1][vt] = mma16(vf, pf[1], o[1][vt]); }
            }
            if (more) {
                LAS bf16_t* Kn = Kb + (cur ^ 1) * KB_BUF; LAS bf16_t* Vn = Vb + (cur ^ 1) * VB_BUF;
#pragma unroll
                for (int i = 0; i < 2; ++i) { const int id = tid + 512 * i, s = id >> 9, row = (id >> 4) & 31, ch = id & 15; *(LAS u32x4*)(Kn + (s * 32 + row) * KP + ch * 8) = kr[i]; }
#pragma unroll
                for (int i = 0; i < 2; ++i) { const int id = tid + 512 * i, row = id >> 5, ch = id & 31; *(LAS u32x4*)(Vn + row * VP + ch * 8) = vr[i]; }
            }
            __syncthreads();
        }
        l0 += __shfl_xor(l0, 16); l0 += __shfl_xor(l0, 32); l1 += __shfl_xor(l1, 16); l1 += __shfl_xor(l1, 32);
        const float i0 = 1.0f / l0, i1 = lam / l1; float ss = 0.f;
#pragma unroll
        for (int vt = 0; vt < 16; ++vt) { o[0][vt] = o[0][vt] * i0 - o[1][vt] * i1; const f32x4 a = o[0][vt]; ss += (a[0] * a[0] + a[1] * a[1]) + (a[2] * a[2] + a[3] * a[3]); }
        ss += __shfl_xor(ss, 16); ss += __shfl_xor(ss, 32);
        const float rs = (1.0f / sqrtf(ss * (1.f / 256.f) + EPS)) * (1.0f - LAM_INIT);
        {   LAS bf16_t* Ow = Qw;
#pragma unroll
            for (int vt = 0; vt < 16; ++vt) { const f32x4 g = *(const f32x4*)(subg + 16 * vt + 4 * fq);
                u32x2 w; w.x = cvtpk(o[0][vt][0] * rs * g[0], o[0][vt][1] * rs * g[1]); w.y = cvtpk(o[0][vt][2] * rs * g[2], o[0][vt][3] * rs * g[3]);
                *(LAS u32x2*)(Ow + fr * 264 + 16 * vt + 4 * fq) = w; }
            asm volatile("s_waitcnt lgkmcnt(0)" ::: "memory");
#pragma unroll
            for (int i = 0; i < 8; ++i) { const int row = 2 * i + (lane >> 5), ch = lane & 31;
                const u32x4 v = *(const LAS u32x4*)(Ow + row * 264 + ch * 8);
                *(u32x4*)(oa + (rb + qw0 + row) * DM + h * 256 + ch * 8) = v; }
            asm volatile("s_waitcnt lgkmcnt(0)" ::: "memory"); }
    }
}

__device__ __forceinline__ unsigned short f2bf1(float x) { return (unsigned short)(cvtpk(x, 0.f) & 0xffffu); }
__device__ __forceinline__ void gla_pre_phase(LAS unsigned char* lds, const bf16_t* proj, const bf16_t* hn, const bf16_t* wlr, const float* wa2, const float* ba, bf16_t* QT, bf16_t* KT, bf16_t* KH, float* DEC, int wg, int nwg, int tid) {
    LAS float* alr = (LAS float*)lds;
    LAS float* tot = alr + 1024;
    LAS float* bl = tot + 256;
    LAS float* bbL = bl + 256;
    constexpr int BP = 260;
    const int d = tid & 255, half = tid >> 8;
    const int lane = tid & 63, wave = __builtin_amdgcn_readfirstlane(tid >> 6), fr = lane & 15, fq = lane >> 4;
    LAS float* part = bbL;
    for (int bc = wg; bc < NB * GLA_NC; bc += nwg) {
      const size_t t0 = (size_t)bc * 64;
      {
          const int tt = wave & 3, kh = wave >> 2;
          const bf16_t* ap = hn + (t0 + 16 * tt + fr) * DM + kh * 1024 + 8 * fq;
          const bf16_t* bp = wlr + (size_t)fr * DM + kh * 1024 + 8 * fq;
          f32x4 acc = (f32x4){0.f, 0.f, 0.f, 0.f};
#pragma unroll 8
          for (int ks = 0; ks < 32; ++ks) acc = mma16(*(const bf16x8*)(ap + 32 * ks), *(const bf16x8*)(bp + 32 * ks), acc);
          if (kh == 1) *(LAS f32x4*)(part + (tt * 64 + lane) * 4) = acc;
          __syncthreads();
          if (kh == 0) { const f32x4 o = acc + *(const LAS f32x4*)(part + (tt * 64 + lane) * 4);
#pragma unroll
              for (int rr = 0; rr < 4; ++rr) alr[(16 * tt + 4 * fq + rr) * 16 + fr] = o[rr]; }
          __syncthreads();
      }
      for (int h = 0; h < GLA_H; ++h) {
        float w[16];
#pragma unroll
        for (int r = 0; r < 16; ++r) w[r] = wa2[r * GLA_DK + h * 256 + d];
        const float bias = ba[h * 256 + d];
        __syncthreads();
        float cum = 0.f;
#pragma unroll 8
        for (int i = 0; i < 32; ++i) { const int t = half * 32 + i; float z = bias;
            const LAS f32x4* ap = (const LAS f32x4*)(alr + t * 16);
#pragma unroll
            for (int r4 = 0; r4 < 4; ++r4) { const f32x4 av = ap[r4]; z += av[0] * w[4 * r4] + av[1] * w[4 * r4 + 1] + av[2] * w[4 * r4 + 2] + av[3] * w[4 * r4 + 3]; }
            const float la = (fminf(z, 0.f) - __logf(1.0f + __expf(-fabsf(z)))) * (1.0f / 16.0f);
            cum += la; bbL[t * BP + d] = cum; }
        if (half == 0) tot[d] = cum;
        __syncthreads();
        if (half == 1) { const float blv = cum + tot[d]; bl[d] = blv; DEC[(size_t)bc * GLA_DK + h * 256 + d] = __expf(blv); }
        __syncthreads();
#pragma unroll
        for (int i = 0; i < 4; ++i) { const int id = tid + 512 * i, t = id >> 5, dg = (id & 31) * 8;
            const size_t row = t0 + t;
            const u32x4 qv = *(const u32x4*)(proj + row * GLA_PP + h * 256 + dg), kv = *(const u32x4*)(proj + row * GLA_PP + 1024 + h * 256 + dg);
            u32x4 oq, oh;
#pragma unroll
            for (int e = 0; e < 4; ++e) {
                float b0 = bbL[t * BP + dg + 2 * e], b1 = bbL[t * BP + dg + 2 * e + 1];
                if (t >= 32) { b0 += tot[dg + 2 * e]; b1 += tot[dg + 2 * e + 1]; }
                const float l0 = bl[dg + 2 * e], l1 = bl[dg + 2 * e + 1];
                const float q0 = bflo(qv[e]), q1 = bfhi(qv[e]), k0 = bflo(kv[e]), k1 = bfhi(kv[e]);
                oq[e] = cvtpk(q0 * __expf(b0) * (1.0f / 16.0f), q1 * __expf(b1) * (1.0f / 16.0f));
                oh[e] = cvtpk(k0 * __expf(l0 - b0), k1 * __expf(l1 - b1)); }
            const size_t oidx = row * GLA_DK + h * 256 + dg;
            *(u32x4*)(QT + oidx) = oq; *(u32x4*)(KH + oidx) = oh; }
        __syncthreads();
      }
    }
}

__device__ __forceinline__ void gla_seq_phase(LAS unsigned char* lds, const bf16_t* QT, const bf16_t* KH, const bf16_t* proj, const float* DEC, bf16_t* OI, int wg, int nwg, int tid) {
    const int lane = tid & 63, wave = __builtin_amdgcn_readfirstlane(tid >> 6), fr = lane & 15, fq = lane >> 4;
    constexpr int QP = 272, KHP = 272, VP = 48;
    LAS bf16_t* Qt = (LAS bf16_t*)lds;
    LAS bf16_t* Kh = (LAS bf16_t*)(lds + 34816);
    LAS bf16_t* Vt = (LAS bf16_t*)(lds + 69632);
    LAS float* dec = (LAS float*)(lds + 75776);
    LAS bf16_t* SBt = (LAS bf16_t*)(lds + 76800);
    LAS bf16_t* Ost = (LAS bf16_t*)(lds + 111616);
    for (int u = wg; u < 256; u += nwg) {
        const int uj = u >> 3, ubh = (u & 7) * 2 + (uj >> 4), vs = uj & 15, h = ubh & 3, b = ubh >> 2;
        const size_t tb0 = (size_t)b * SEQ;
        const bf16_t* qsrc = QT + tb0 * GLA_DK + h * 256;
        const bf16_t* ksrc = KH + tb0 * GLA_DK + h * 256;
        const bf16_t* vsrc = proj + tb0 * GLA_PP + 2048 + h * 512 + vs * 32;
        const float* dsrc = DEC + (size_t)b * GLA_NC * GLA_DK + h * 256;
        for (int i = tid; i < 32 * QP / 2; i += NTHR) ((LAS unsigned*)SBt)[i] = 0u;
        f32x4 S[2][2];
#pragma unroll
        for (int a = 0; a < 2; ++a)
#pragma unroll
            for (int c = 0; c < 2; ++c) S[a][c] = (f32x4){0.f, 0.f, 0.f, 0.f};
        u32x4 qr[4], kr[4], vr, dr;
        vr = (u32x4){0u, 0u, 0u, 0u}; dr = vr;
#define GLA_SEQ_LOAD(c) do { \
            _Pragma("unroll") for (int i = 0; i < 4; ++i) { const int id = tid + 512 * i, row = id >> 5, ch = id & 31; \
                qr[i] = *(const u32x4*)(qsrc + (size_t)((c) * 64 + row) * GLA_DK + ch * 8); kr[i] = *(const u32x4*)(ksrc + (size_t)((c) * 64 + row) * GLA_DK + ch * 8); } \
            if (tid < 256) { const int row = tid >> 2, ch = tid & 3; vr = *(const u32x4*)(vsrc + (size_t)((c) * 64 + row) * GLA_PP + ch * 8); } \
            else if (tid < 320) { dr = *(const u32x4*)(dsrc + (size_t)(c) * GLA_DK + (tid - 256) * 4); } } while (0)
#define GLA_SEQ_STORE() do { \
            _Pragma("unroll") for (int i = 0; i < 4; ++i) { const int id = tid + 512 * i, row = id >> 5, ch = id & 31; \
                *(LAS u32x4*)(Qt + row * QP + ch * 8) = qr[i]; *(LAS u32x4*)(Kh + row * KHP + ch * 8) = kr[i]; } \
            if (tid < 256) { const int row = tid >> 2, ch = tid & 3; *(LAS u32x4*)(Vt + row * VP + ch * 8) = vr; } \
            else if (tid < 320) { *(LAS u32x4*)(dec + (tid - 256) * 4) = dr; } } while (0)
        GLA_SEQ_LOAD(0);
        GLA_SEQ_STORE();
        __syncthreads();
        for (int c = 0; c < GLA_NC; ++c) {
            const int cur = c & 1;
            if (c + 1 < GLA_NC) GLA_SEQ_LOAD(c + 1);
            const LAS bf16_t* Sc = SBt + cur * 32 * QP; LAS bf16_t* Sn = SBt + (cur ^ 1) * 32 * QP;
            {
                const int vt = wave & 1, tt = wave >> 1; f32x4 acc = (f32x4){0.f, 0.f, 0.f, 0.f};
#pragma unroll
                for (int ks = 0; ks < 8; ++ks) acc = mma16(frag_rowk(Sc, QP, 16 * vt, 32 * ks, fr, fq), frag_rowk(Qt, QP, 16 * tt, 32 * ks, fr, fq), acc);
                { u32x2 w; w.x = cvtpk(acc[0], acc[1]); w.y = cvtpk(acc[2], acc[3]); *(LAS u32x2*)(Ost + (16 * tt + fr) * 32 + 16 * vt + 4 * fq) = w; }
            }
#pragma unroll
            for (int dl = 0; dl < 2; ++dl) { const f32x4 d4 = *(const LAS f32x4*)(dec + 16 * (2 * wave + dl) + 4 * fq);
#pragma unroll
                for (int vt = 0; vt < 2; ++vt) S[dl][vt] = S[dl][vt] * d4; }
#pragma unroll
            for (int ks = 0; ks < 2; ++ks) {
                bf16x8 bfr[2];
#pragma unroll
                for (int vt = 0; vt < 2; ++vt) bfr[vt] = frag_tr2(Vt, VP, 32 * ks + 4 * fq, 32 * ks + 16 + 4 * fq, 16 * vt, fr);
#pragma unroll
                for (int dl = 0; dl < 2; ++dl) { const bf16x8 af = frag_tr2(Kh, KHP, 32 * ks + 4 * fq, 32 * ks + 16 + 4 * fq, 16 * (2 * wave + dl), fr);
#pragma unroll
                    for (int vt = 0; vt < 2; ++vt) S[dl][vt] = mma16(af, bfr[vt], S[dl][vt]); }
            }
#pragma unroll
            for (int dl = 0; dl < 2; ++dl)
#pragma unroll
                for (int vt = 0; vt < 2; ++vt) { u32x2 w; w.x = cvtpk(S[dl][vt][0], S[dl][vt][1]); w.y = cvtpk(S[dl][vt][2], S[dl][vt][3]);
                    *(LAS u32x2*)(Sn + (16 * vt + fr) * QP + 16 * (2 * wave + dl) + 4 * fq) = w; }
            __syncthreads();
            if (c + 1 < GLA_NC) GLA_SEQ_STORE();
            if (tid < 256) *(u32x4*)(OI + ((((tb0 >> 6) + c) * 4 + h) * 16 + vs) * 2048 + tid * 8) = *(const LAS u32x4*)(Ost + tid * 8);
            __syncthreads();
        }
#undef GLA_SEQ_LOAD
#undef GLA_SEQ_STORE
    }
}

__device__ __forceinline__ void gla_post_phase(LAS unsigned char* lds, const bf16_t* QT, const bf16_t* KT  , const float* DEC, const bf16_t* proj, const bf16_t* OI, const float* gnorm, bf16_t* OG, int wg, int nwg, int tid) {
    const int lane = tid & 63, wave = __builtin_amdgcn_readfirstlane(tid >> 6), fr = lane & 15, fq = lane >> 4;
    constexpr int QP = 272, PP = 80, VP = 528;
    LAS bf16_t* Qt = (LAS bf16_t*)lds;
    LAS bf16_t* Kt = (LAS bf16_t*)(lds + 34816);
    LAS bf16_t* P = (LAS bf16_t*)(lds + 69632);
    LAS bf16_t* V = (LAS bf16_t*)(lds + 79872);
    LAS float* red = (LAS float*)(lds + 147456);
    for (int u = wg; u < NB * GLA_NC * GLA_H; u += nwg) {
        const int h = u & 3, bc = u >> 2; const size_t t0 = (size_t)bc * 64;
        float idc[8];
        { const float* dp = DEC + (size_t)bc * GLA_DK + h * 256 + (tid & 31) * 8; const f32x4 d0 = *(const f32x4*)dp, d1 = *(const f32x4*)(dp + 4);
          idc[0] = 1.0f / d0[0]; idc[1] = 1.0f / d0[1]; idc[2] = 1.0f / d0[2]; idc[3] = 1.0f / d0[3]; idc[4] = 1.0f / d1[0]; idc[5] = 1.0f / d1[1]; idc[6] = 1.0f / d1[2]; idc[7] = 1.0f / d1[3]; }
#pragma unroll
        for (int i = 0; i < 4; ++i) { const int id = tid + 512 * i, row = id >> 5, ch = id & 31;
            const u32x4 qv = *(const u32x4*)(QT + (t0 + row) * GLA_DK + h * 256 + ch * 8);
            u32x4 qs; qs.x = cvtpk(bflo(qv.x) * idc[0], bfhi(qv.x) * idc[1]); qs.y = cvtpk(bflo(qv.y) * idc[2], bfhi(qv.y) * idc[3]);
            qs.z = cvtpk(bflo(qv.z) * idc[4], bfhi(qv.z) * idc[5]); qs.w = cvtpk(bflo(qv.w) * idc[6], bfhi(qv.w) * idc[7]);
            *(LAS u32x4*)(Qt + row * QP + ch * 8) = qs;
            *(LAS u32x4*)(Kt + row * QP + ch * 8) = *(const u32x4*)(KT + (t0 + row) * GLA_DK + h * 256 + ch * 8); }
#pragma unroll
        for (int i = 0; i < 8; ++i) { const int id = tid + 512 * i, row = id >> 6, ch = id & 63;
            *(LAS u32x4*)(V + row * VP + ch * 8) = *(const u32x4*)(proj + (t0 + row) * GLA_PP + 2048 + h * 512 + ch * 8); }
        __syncthreads();
        {
            const int st_ = wave >> 1;
#pragma unroll
            for (int e = 0; e < 2; ++e) { const int tt = 2 * (wave & 1) + e; f32x4 acc = (f32x4){0.f, 0.f, 0.f, 0.f};
#pragma unroll
                for (int ks = 0; ks < 8; ++ks) acc = mma16(frag_rowk(Kt, QP, 16 * st_, 32 * ks, fr, fq), frag_rowk(Qt, QP, 16 * tt, 32 * ks, fr, fq), acc);
                const int t = 16 * tt + fr, s0 = 16 * st_ + 4 * fq;
                u32x2 w; w.x = cvtpk(s0 <= t ? acc[0] : 0.f, s0 + 1 <= t ? acc[1] : 0.f); w.y = cvtpk(s0 + 2 <= t ? acc[2] : 0.f, s0 + 3 <= t ? acc[3] : 0.f);
                *(LAS u32x2*)(P + t * PP + 32 * (st_ >> 1) + 8 * fq + 4 * (st_ & 1)) = w; }
        }
        __syncthreads();
        f32x4 acc[4][4];
#pragma unroll
        for (int vt = 0; vt < 4; ++vt)
#pragma unroll
            for (int tt = 0; tt < 4; ++tt) acc[vt][tt] = (f32x4){0.f, 0.f, 0.f, 0.f};
#pragma unroll
        for (int ks = 0; ks < 2; ++ks) {
            bf16x8 pb[4];
#pragma unroll
            for (int tt = 0; tt < 4; ++tt) pb[tt] = frag_rowk(P, PP, 16 * tt, 32 * ks, fr, fq);
#pragma unroll
            for (int vt = 0; vt < 4; ++vt) { const int cb = 64 * wave + 32 * (vt >> 1) + 8 * (fr & 3) + 4 * (vt & 1);
                const LAS bf16_t* pa = V + (32 * ks + 4 * fq + (fr >> 2)) * VP + cb;
                const s16x4 ta = __builtin_amdgcn_ds_read_tr16_b64_v4i16((LAS s16x4*)pa), tb2 = __builtin_amdgcn_ds_read_tr16_b64_v4i16((LAS s16x4*)(pa + 16 * VP));
                const bf16x8 af = (bf16x8){ta[0], ta[1], ta[2], ta[3], tb2[0], tb2[1], tb2[2], tb2[3]};
#pragma unroll
                for (int tt = 0; tt < 4; ++tt) acc[vt][tt] = mma16(af, pb[tt], acc[vt][tt]); }
        }
        float ss[4];
#pragma unroll
        for (int tt = 0; tt < 4; ++tt) { ss[tt] = 0.f;
#pragma unroll
            for (int P2 = 0; P2 < 2; ++P2) { const u32x4 oiw = *(const u32x4*)(OI + (((size_t)bc * 4 + h) * 16 + 2 * wave + P2) * 2048 + (16 * tt + fr) * 32 + 8 * fq);
                const f32x4 o0 = (f32x4){bflo(oiw.x), bfhi(oiw.x), bflo(oiw.y), bfhi(oiw.y)}, o1 = (f32x4){bflo(oiw.z), bfhi(oiw.z), bflo(oiw.w), bfhi(oiw.w)};
                acc[2 * P2][tt] = acc[2 * P2][tt] + o0; acc[2 * P2 + 1][tt] = acc[2 * P2 + 1][tt] + o1;
                const f32x4 a = acc[2 * P2][tt], c = acc[2 * P2 + 1][tt];
                ss[tt] += ((a[0] * a[0] + a[1] * a[1]) + (a[2] * a[2] + a[3] * a[3])) + ((c[0] * c[0] + c[1] * c[1]) + (c[2] * c[2] + c[3] * c[3])); }
            ss[tt] += __shfl_xor(ss[tt], 16); ss[tt] += __shfl_xor(ss[tt], 32);
            if (fq == 0) red[(16 * tt + fr) * 8 + wave] = ss[tt]; }
        __syncthreads();
#pragma unroll
        for (int tt = 0; tt < 4; ++tt) { const LAS f32x4* rp = (const LAS f32x4*)(red + (16 * tt + fr) * 8); const f32x4 r0 = rp[0], r1 = rp[1];
            const float tot = ((r0[0] + r0[1]) + (r0[2] + r0[3])) + ((r1[0] + r1[1]) + (r1[2] + r1[3]));
            const float rs = 1.0f / sqrtf(tot * (1.f / 512.f) + EPS); const size_t row = t0 + 16 * tt + fr;
#pragma unroll
            for (int P2 = 0; P2 < 2; ++P2) { const int v = 64 * wave + 32 * P2 + 8 * fq;
                const u32x4 rr = *(const u32x4*)(proj + row * GLA_PP + 4096 + h * 512 + v); const f32x4 g0 = *(const f32x4*)(gnorm + v), g1 = *(const f32x4*)(gnorm + v + 4);
                const f32x4 a = acc[2 * P2][tt], c = acc[2 * P2 + 1][tt];
                u32x4 w; w.x = cvtpk(a[0] * rs * g0[0] * pg8::silu_f(bflo(rr.x)), a[1] * rs * g0[1] * pg8::silu_f(bfhi(rr.x)));
                w.y = cvtpk(a[2] * rs * g0[2] * pg8::silu_f(bflo(rr.y)), a[3] * rs * g0[3] * pg8::silu_f(bfhi(rr.y)));
                w.z = cvtpk(c[0] * rs * g1[0] * pg8::silu_f(bflo(rr.z)), c[1] * rs * g1[1] * pg8::silu_f(bfhi(rr.z)));
                w.w = cvtpk(c[2] * rs * g1[2] * pg8::silu_f(bflo(rr.w)), c[3] * rs * g1[3] * pg8::silu_f(bfhi(rr.w)));
                *(u32x4*)(OG + row * DM + h * 512 + v) = w; } }
        __syncthreads();
    }
}

#define XB_TMO      128
#define XB_XCNT(j)  (256  + 64 * (j))
#define XB_XSUB(j)  (1280 + 64 * (j))
#define XB_XGEN(j)  (2304 + 64 * (j))
#define XB_TOP      3328
#define XB_TOPGEN   3392
#define XCD_BAR_WORDS 3456
#define XB_SPIN_CAP (1u << 18)

__device__ __forceinline__ unsigned xb_ld(unsigned* p)              { return __hip_atomic_load(p, __ATOMIC_RELAXED, __HIP_MEMORY_SCOPE_AGENT); }
__device__ __forceinline__ unsigned xb_add(unsigned* p, unsigned v) { return __hip_atomic_fetch_add(p, v, __ATOMIC_RELAXED, __HIP_MEMORY_SCOPE_AGENT); }
__device__ __forceinline__ unsigned xb_xcc_id() { return (unsigned)__builtin_amdgcn_s_getreg((3 << 11) | 20) & 0xFu; }
#define XB_SPIN(cond, bar) do { unsigned _sp = 0; while (cond) { __builtin_amdgcn_s_sleep(1); \
    if ((++_sp & 255u) == 0u) { if (xb_ld(&(bar)[XB_TMO])) break; if (_sp > XB_SPIN_CAP) { atomicAdd(&(bar)[XB_TMO], 1u); break; } } } } while (0)

struct XcdBarrier {
    unsigned* bar; unsigned x;
    volatile LAS unsigned* st;
};

__device__ __forceinline__ XcdBarrier xcd_barrier_post(unsigned* bar, volatile LAS unsigned* st) {
    XcdBarrier b; b.bar = bar; b.x = xb_xcc_id(); b.st = st;
    if (threadIdx.x == 0) (void)xb_add(&bar[XB_XCNT(b.x)], 1u);
    return b;
}
__device__ __forceinline__ void xcd_barrier_complete(unsigned* bar, unsigned x, unsigned& nloc, unsigned& nx) {
    const unsigned G = gridDim.x * gridDim.y * gridDim.z;
    unsigned sum, cnt, mine, sp = 0u;
    for (;;) {
        sum = 0u; cnt = 0u; mine = 0u;
#pragma unroll
        for (unsigned j = 0; j < 16; ++j) { const unsigned c = xb_ld(&bar[XB_XCNT(j)]); sum += c; cnt += (c > 0u) ? 1u : 0u; mine = (j == x) ? c : mine; }
        if (sum == G) break;
        __builtin_amdgcn_s_sleep(1);
        if ((++sp & 255u) == 0u) { if (xb_ld(&bar[XB_TMO])) break; if (sp > XB_SPIN_CAP) { atomicAdd(&bar[XB_TMO], 1u); break; } }
    }
    nloc = mine > 0u ? mine : 1u; nx = cnt > 0u ? cnt : 1u;
}

__device__ __forceinline__ void xcd_barrier(const XcdBarrier& b) {
    asm volatile("s_waitcnt vmcnt(0)" ::: "memory");
    __syncthreads();
    if (threadIdx.x == 0) {
        unsigned* bar = b.bar;
        __builtin_amdgcn_s_waitcnt(0);
        unsigned nloc = b.st[0], nx = b.st[1];
        if (nloc == 0u) { xcd_barrier_complete(bar, b.x, nloc, nx); b.st[0] = nloc; b.st[1] = nx; }
        const unsigned old = xb_add(&bar[XB_XSUB(b.x)], 1u);
        const unsigned gen = old / nloc;
        if (old + 1u == (gen + 1u) * nloc) {
            __builtin_amdgcn_fence(__ATOMIC_RELEASE, "agent");
            asm volatile("s_waitcnt vmcnt(0)" ::: "memory");
            const unsigned og = xb_add(&bar[XB_TOP], 1u);
            const unsigned tg = og / nx;
            if (og + 1u == (tg + 1u) * nx) xb_add(&bar[XB_TOPGEN], 1u);
            else XB_SPIN(xb_ld(&bar[XB_TOPGEN]) == tg, bar);
            __builtin_amdgcn_fence(__ATOMIC_ACQUIRE, "agent");
            xb_add(&bar[XB_XGEN(b.x)], 1u);
            asm volatile("s_waitcnt vmcnt(0)" ::: "memory");
        } else {
            XB_SPIN(xb_ld(&bar[XB_XGEN(b.x)]) == gen, bar);
            __builtin_amdgcn_fence(__ATOMIC_ACQUIRE, "agent");
            asm volatile("s_waitcnt vmcnt(0)" ::: "memory");
        }
    }
    __syncthreads();
}

#ifndef PMASK
#define PMASK 0xFFFF
#endif
#define PON(k) ((PMASK >> (k)) & 1)
#ifndef RMASK
#define RMASK 0
#endif
#define RPT(k) (((RMASK >> (k)) & 1) ? 2 : 1)
#define REP(k, body) for (int rp_ = 0; rp_ < RPT(k); ++rp_) { body; if (rp_ + 1 < RPT(k)) GSYNC(); }
__global__ void __launch_bounds__(NTHR) mega_fwd(Args a) {
    extern __shared__ __attribute__((aligned(16))) unsigned char lds_raw[];
    cg::grid_group grid = cg::this_grid();
    LAS unsigned char* lds = (LAS unsigned char*)lds_raw;
    const int G = gridDim.x, wg = blockIdx.x;
    const int ngw = G * NWAVES, ngt = G * NTHR;
    unsigned char* ws = a.ws;
    const float* x_in = a.in[0]; const float* norm_g = a.in[1];
    float* X = a.out;
    bf16_t* W_GLA_IN = (bf16_t*)(ws + WS_GLA_IN); bf16_t* W_GLA_OUT = (bf16_t*)(ws + WS_GLA_OUT); bf16_t* W_POOL = (bf16_t*)(ws + WS_POOL);
    bf16_t* W_DIFF_IN = (bf16_t*)(ws + WS_DIFF_IN); bf16_t* W_DIFF_OUT = (bf16_t*)(ws + WS_DIFF_OUT); bf16_t* W_GU = (bf16_t*)(ws + WS_GU); bf16_t* W_DOWN = (bf16_t*)(ws + WS_DOWN);
    bf16_t* HN = (bf16_t*)(ws + WS_HN); bf16_t* PROJ = (bf16_t*)(ws + WS_PROJ); bf16_t* HID = (bf16_t*)(ws + WS_HID);
    bf16_t* QT = (bf16_t*)(ws + WS_QT); bf16_t* KT = (bf16_t*)(ws + WS_KT); bf16_t* KH = (bf16_t*)(ws + WS_KH);
    bf16_t* XB = (bf16_t*)(ws + WS_XB); float* DEC = (float*)(ws + WS_DEC); bf16_t* OI = (bf16_t*)(ws + WS_OI); bf16_t* OG = (bf16_t*)(ws + WS_OG);
    const int lo = a.lo, hi = a.hi; int seam = 0; bool final_phase = false;
    volatile LAS unsigned* MISC = (volatile LAS unsigned*)(lds + MISC_OFF);
    if (threadIdx.x < 16) MISC[threadIdx.x] = 0u;
    __syncthreads();
    const XcdBarrier xbar = xcd_barrier_post((unsigned*)(ws + WS_BAR), MISC);
#define PH_BEGIN if (seam >= lo && seam < hi) { int tid = threadIdx.x; asm volatile("" : "+v"(tid)); const int lane = tid & 63, wave = __builtin_amdgcn_readfirstlane(tid >> 6); const int gw = wg * NWAVES + wave, gtid = wg * NTHR + tid; (void)lane; (void)gw; (void)gtid;
#define GSYNC() do { if (lo < 0) grid.sync(); xcd_barrier(xbar); } while (0)
#define PH_END   if (seam + 1 < hi && !final_phase) GSYNC(); } ++seam;

    PH_BEGIN
#if PON(0)
        for (int rp0 = 0; rp0 < RPT(0); ++rp0) {
        LAS float* scr = (LAS float*)(lds + wave * 17408);
        for (int s = 0; s < 2; ++s) {
            conv_matrix(a.in[2] + (size_t)s * DM * GLA_IN, DM, GLA_IN, GLA_INP, W_GLA_IN + (size_t)s * GLA_INP * DM, 0, scr, gw, ngw, lane);
            conv_matrix(a.in[6] + (size_t)s * DM * DM, DM, DM, DM, W_GLA_OUT + (size_t)s * DM * DM, 0, scr, gw, ngw, lane);
        }
        for (int g = 0; g < 4; ++g) conv_matrix(a.in[7] + (size_t)g * 512 * 512, 512, 512, 512, W_POOL + (size_t)g * 512 * 512, 0, scr, gw, ngw, lane, a.in[8] + g * 512);
        conv_matrix(a.in[9], DM, DIFF_IN, DIFF_IN, W_DIFF_IN, 0, scr, gw, ngw, lane);
        conv_matrix(a.in[14], DM, DM, DM, W_DIFF_OUT, 0, scr, gw, ngw, lane);
        for (int l = 0; l < 4; ++l) {
            conv_matrix(a.in[16] + (size_t)l * DM * 2 * FF, DM, 2 * FF, 2 * FF, W_GU + (size_t)l * 2 * FF * DM, 1, scr, gw, ngw, lane);
            conv_matrix(a.in[17] + (size_t)l * FF * DM, FF, DM, DM, W_DOWN + (size_t)l * DM * FF, 0, scr, gw, ngw, lane);
        }
        norm_phase(x_in, norm_g, HN, XB, gw, ngw, lane);
        if (rp0 + 1 < RPT(0)) grid.sync(); }
#endif
    PH_END

    for (int layer = 0; layer < 4; ++layer) {
        const int kind = layer % 3, slot = layer / 3;
        if (kind != 1) {
            PH_BEGIN
                const int N = (kind == 0) ? GLA_PP : DIFF_IN;
                pg8::Gemm g{HN, (kind == 0) ? W_GLA_IN + (size_t)slot * GLA_INP * DM : W_DIFF_IN, M, N, DM, DM, 0};
                pg8::StaticOrder S; S.init(M, N, G, wg);
                pg8::EpiStore E{PROJ, N};
#if PON(1)
                REP(1, (pg8::gemm_phase<pg8::EpiStore, pg8::StaticOrder, true, true>(lds, g, S, E)))
#endif
            PH_END
        }
        if (kind == 0) {
#if PON(2)
            PH_BEGIN REP(2, gla_pre_phase(lds, PROJ, HN, W_GLA_IN + (size_t)slot * GLA_INP * DM + (size_t)6144 * DM, a.in[3] + (size_t)slot * GLA_RANK * GLA_DK, a.in[4] + (size_t)slot * GLA_DK, QT, KT, KH, DEC, wg, G, tid)) PH_END
#endif
#if PON(3)
            PH_BEGIN REP(3, gla_seq_phase(lds, QT, KH, PROJ, DEC, OI, wg, G, tid)) PH_END
#endif
#if PON(4)
            PH_BEGIN REP(4, gla_post_phase(lds, QT, KH, DEC, PROJ, OI, a.in[5] + (size_t)slot * GLA_HV, OG, wg, G, tid)) PH_END
#endif
        } else if (kind == 1) {
#if PON(5)
            PH_BEGIN REP(5, pool_pre_phase(HN, OG, gtid, ngt)) PH_END
#endif
        } else {
#if PON(6)
            PH_BEGIN qknorm_phase(PROJ, a.in[10], a.in[11], gw, ngw, lane); PH_END
#endif
#if PON(7)
            PH_BEGIN REP(7, attn_phase(lds, PROJ, OG, a.in[12], a.in[13], a.in[15], a.in[10], wg, tid)) PH_END
#endif
        }
        for (int pass = 0; pass < 2; ++pass) {
            if (pass == 1) {
                PH_BEGIN REP(10, norm_phase_b(XB, norm_g + (size_t)(layer * 2 + 1) * DM, HN, gw, ngw, lane)) PH_END
                PH_BEGIN
                    pg8::Gemm g{HN, W_GU + (size_t)layer * 2 * FF * DM, M, 2 * FF, DM, DM, 0};
                    pg8::StaticOrder S; S.init(M, 2 * FF, G, wg);
                    pg8::EpiSwiglu E{HID, FF};
#if PON(8)
                    REP(8, (pg8::gemm_phase<pg8::EpiSwiglu, pg8::StaticOrder, true, true>(lds, g, S, E)))
#endif
                PH_END
            }
            PH_BEGIN
                pg8::Gemm g;
                if (pass == 1) g = pg8::Gemm{HID, W_DOWN + (size_t)layer * DM * FF, M, DM, FF, FF, 0};
                else if (kind == 0) g = pg8::Gemm{OG, W_GLA_OUT + (size_t)slot * DM * DM, M, DM, DM, DM, 0};
                else if (kind == 1) g = pg8::Gemm{OG, W_POOL, M, DM, 512, DM, 1};
                else g = pg8::Gemm{OG, W_DIFF_OUT, M, DM, DM, DM, 0};
                pg8::StaticOrder S; S.init(M, DM, G, wg, 4);
                const bool last_add = (layer == 3 && pass == 1); final_phase = last_add;
                pg8::EpiResid E{(const void*)XB, last_add ? (void*)X : (void*)XB, DM, last_add ? 1 : 0};
#if PON(9)
                pg8::gemm_phase<pg8::EpiResid, pg8::StaticOrder, false, true>(lds, g, S, E);
#endif
            PH_END
        }
        if (layer < 3) {
            PH_BEGIN REP(10, norm_phase_b(XB, norm_g + (size_t)((layer + 1) * 2) * DM, HN, gw, ngw, lane)) PH_END
        }
    }
#undef PH_BEGIN
#undef PH_END
}

extern "C" void kernel_launch(void* const* d_in, const int* in_sizes, int n_in, void* d_out, int out_size, void* d_ws, size_t ws_size, hipStream_t stream) {
    static int grid = 0;
    if (grid == 0) {
        if (n_in != 18 || out_size != M * DM || ws_size < WS_END) { fprintf(stderr, "kernel_launch: unexpected shapes (n_in %d out %d ws %zu)\n", n_in, out_size, ws_size); grid = -1; return; }
        int dev = 0, cus = 0, per_cu = 0;
        (void)hipGetDevice(&dev);
        (void)hipDeviceGetAttribute(&cus, hipDeviceAttributeMultiprocessorCount, dev);
        if (hipFuncSetAttribute((const void*)mega_fwd, hipFuncAttributeMaxDynamicSharedMemorySize, LDS_BYTES) != hipSuccess) { fprintf(stderr, "kernel_launch: hipFuncSetAttribute failed\n"); grid = -1; return; }
        if (hipOccupancyMaxActiveBlocksPerMultiprocessor(&per_cu, (const void*)mega_fwd, NTHR, LDS_BYTES) != hipSuccess || per_cu < 1) { fprintf(stderr, "kernel_launch: occupancy query says %d\n", per_cu); per_cu = 1; }
        (void)hipGetLastError();
        grid = cus * per_cu;
        if (grid != 256) { fprintf(stderr, "kernel_launch: built for a 256-workgroup grid (256 CUs x 1), got %d x %d\n", cus, per_cu); if (grid > 256) grid = 256; }
    }
    if (grid < 0) return;
    if (hipMemsetAsync((char*)d_ws + WS_BAR, 0, 16384, stream) != hipSuccess) { fprintf(stderr, "kernel_launch: memset of the barrier words failed\n"); return; }
    Args a{};
    for (int i = 0; i < 18; ++i) a.in[i] = (const float*)d_in[i];
    a.out = (float*)d_out; a.ws = (unsigned char*)d_ws; a.lo = 0; a.hi = 1 << 30;
    void* args[] = {&a};
    hipError_t e = hipLaunchCooperativeKernel((const void*)mega_fwd, dim3(grid), dim3(NTHR), args, LDS_BYTES, stream);
    if (e != hipSuccess) fprintf(stderr, "kernel_launch: cooperative launch failed: %s (grid %d)\n", hipGetErrorString(e), grid);
}
```
